# Optimizing an MI355X kernel written in HIP

```python
import jax
import jax.numpy as jnp
from jax import lax
import numpy as np

D_MODEL = 2048
BATCH = 4
SEQ = 4096
DEPTH = 2

GRID_W = 64
CTX_LEN = 256
HEAD_DIM = 128
EPS = 1e-6
N_MOD = 9
N_BRANCH = 3
FFN_DIM = 256 * ((8 * D_MODEL // 3 + 255) // 256)
A_GROUPS = D_MODEL // (4 * HEAD_DIM)
A_CHUNK = 128
A_WIDTH = A_GROUPS * HEAD_DIM
B_HEADS = D_MODEL // (4 * HEAD_DIM)
B_DK = HEAD_DIM // 2
B_DV = HEAD_DIM
B_KW = B_HEADS * B_DK
B_VW = B_HEADS * B_DV
B_RANK = 16
B_TAU = 16.0
B_CHUNK = 64
C_HEADS = D_MODEL // (2 * HEAD_DIM)
C_KV_HEADS = C_HEADS // 4
C_QW = C_HEADS * HEAD_DIM
C_KVW = C_KV_HEADS * HEAD_DIM
C_WINDOW = 128
C_BLOCK = 128
ROPE_BASE = 10000.0
COL_BK = 0
COL_BV = COL_BK + B_KW
COL_CK = COL_BV + B_VW
COL_CV = COL_CK + C_KVW
CTX_STATE_COLS = COL_CV + C_KVW
COL_AU = CTX_STATE_COLS
COL_AV = COL_AU + A_WIDTH
COL_BQ = COL_AV + A_WIDTH
COL_BG = COL_BQ + B_KW
COL_CQ = COL_BG + B_VW
COL_GATE = COL_CQ + C_QW
IN_COLS = COL_GATE + N_BRANCH * D_MODEL

kernel_name = 'hybrid_gmlp_gla_swa_macaron_dit'


def rms_norm(x, gain):
    xf = x.astype(jnp.float32)
    y = xf * lax.rsqrt(jnp.mean(xf * xf, axis=-1, keepdims=True) + EPS)
    return (y * gain.astype(jnp.float32)).astype(x.dtype)


def layer_norm(x, gain):
    xf = x.astype(jnp.float32)
    mu = jnp.mean(xf, axis=-1, keepdims=True)
    var = jnp.mean(jnp.square(xf - mu), axis=-1, keepdims=True)
    return ((xf - mu) * lax.rsqrt(var + EPS) * gain.astype(jnp.float32)).astype(x.dtype)


def modulate(h, shift, scale):
    return h * (1 + scale) + shift


def swiglu(h, w_up, w_down):
    gate, val = jnp.split(h @ w_up, 2, axis=-1)
    return (jax.nn.silu(gate) * val) @ w_down


def cols(z, start, width):
    return z[..., start:start + width]


def heads(z, start, width, n, d):
    return cols(z, start, width).reshape(z.shape[0], z.shape[1], n, d)


def flip(t):
    return jnp.flip(t, axis=1)


def rope_axis(x, pos):
    half = x.shape[-1] // 2
    inv_freq = ROPE_BASE ** (-jnp.arange(half, dtype=jnp.float32) / half)
    ang = pos.astype(jnp.float32)[:, None] * inv_freq[None, :]
    cos = jnp.cos(ang)[:, None, :]
    sin = jnp.sin(ang)[:, None, :]
    xf = x.astype(jnp.float32)
    x1, x2 = xf[..., :half], xf[..., half:]
    return jnp.concatenate([x1 * cos - x2 * sin, x1 * sin + x2 * cos], axis=-1).astype(x.dtype)


def rope_2d(x):
    L = x.shape[1]
    rows = L // GRID_W
    row = jnp.repeat(jnp.arange(rows), GRID_W)
    col = jnp.tile(jnp.arange(GRID_W), rows)
    ax = x.shape[-1] // 2
    return jnp.concatenate([rope_axis(x[..., :ax], row), rope_axis(x[..., ax:], col)], axis=-1)


def chunk_spatial_gating(u, v, v_gain, w_s, b_s):
    B_, L, _ = u.shape
    u = jax.nn.gelu(u)
    v = layer_norm(jax.nn.gelu(v), v_gain)
    vr = v.reshape(B_, L // A_CHUNK, A_CHUNK, A_GROUPS, HEAD_DIM)
    mixed = jnp.einsum('gpq,bnqgd->bnpgd', w_s, vr) + b_s.T[None, None, :, :, None]
    return u * mixed.reshape(B_, L, A_WIDTH)


def gla_log_decay(h, w1, w2, bias):
    logit = ((h @ w1) @ w2 + bias).astype(jnp.float32)
    return (jax.nn.log_sigmoid(logit) / B_TAU).reshape(h.shape[0], h.shape[1], B_HEADS, B_DK)


def gla_chunked(q, k, v, g, s0):
    B_, L, H, _ = q.shape
    n = L // B_CHUNK

    def to_chunks(t):
        return t.reshape(B_, n, B_CHUNK, H, t.shape[-1]).transpose(1, 0, 3, 2, 4)

    qc, kc, vc, gc = to_chunks(q), to_chunks(k), to_chunks(v), to_chunks(g)
    bc = jnp.cumsum(gc, axis=3)
    b_last = bc[:, :, :, -1:, :]
    q_in = qc * jnp.exp(bc)
    k_in = kc * jnp.exp(-bc)
    k_out = kc * jnp.exp(b_last - bc)
    mask = jnp.tril(jnp.ones((B_CHUNK, B_CHUNK), dtype=bool))
    attn = jnp.where(mask, jnp.einsum('nbhtd,nbhsd->nbhts', q_in, k_in), 0.0)
    intra = jnp.einsum('nbhts,nbhsv->nbhtv', attn, vc)

    def step(s, inp):
        qi, ko, vi, bl = inp
        o = jnp.einsum('bhtd,bhdv->bhtv', qi, s)
        s = s * jnp.exp(bl[:, :, 0, :])[..., None] + jnp.einsum('bhsd,bhsv->bhdv', ko, vi)
        return s, o

    s_fin, inter = lax.scan(step, s0, (q_in, k_out, vc, b_last))
    o = (intra + inter).transpose(1, 0, 3, 2, 4).reshape(B_, L, H, v.shape[-1])
    return o, s_fin


def gla_final_state(k, v, g):
    b = jnp.cumsum(g, axis=1)
    w = jnp.exp(b[:, -1:] - b)
    return jnp.einsum('blhd,blhv->bhdv', k * w, v)


def gla_output(o, og, gain):
    o = rms_norm(o, gain).reshape(o.shape[0], o.shape[1], B_VW).astype(og.dtype)
    return o * jax.nn.silu(og)


def window_attention(q, k, v, k_ctx, v_ctx, sink):
    B_, L, H, D = q.shape
    KV = k.shape[2]
    G = H // KV
    nb = L // C_BLOCK
    scale = D ** -0.5
    qb = q.reshape(B_, nb, C_BLOCK, KV, G, D)
    pad = ((0, 0), (C_BLOCK, C_BLOCK), (0, 0), (0, 0))

    def band(t):
        tp = jnp.pad(t, pad).reshape(B_, nb + 2, C_BLOCK, KV, D)
        return jnp.concatenate([tp[:, :-2], tp[:, 1:-1], tp[:, 2:]], axis=2)

    kb, vb = band(k), band(v)
    s_loc = jnp.einsum('bnqkgd,bnjkd->bkgnqj', qb, kb).astype(jnp.float32) * scale
    qpos = jnp.arange(nb)[:, None] * C_BLOCK + jnp.arange(C_BLOCK)[None, :]
    kpos = jnp.arange(nb)[:, None] * C_BLOCK - C_BLOCK + jnp.arange(3 * C_BLOCK)[None, :]
    valid = ((jnp.abs(qpos[:, :, None] - kpos[:, None, :]) <= C_WINDOW)
             & (kpos[:, None, :] >= 0) & (kpos[:, None, :] < L))
    s_loc = jnp.where(valid, s_loc, -jnp.inf)
    s_ctx = jnp.einsum('bnqkgd,bjkd->bkgnqj', qb, k_ctx).astype(jnp.float32) * scale
    s_sink = jnp.broadcast_to(sink.astype(jnp.float32).reshape(KV, G)[None, :, :, None, None, None],
                              s_loc.shape[:-1] + (1,))
    p = jax.nn.softmax(jnp.concatenate([s_loc, s_ctx, s_sink], axis=-1), axis=-1)
    n_loc = 3 * C_BLOCK
    n_ctx = k_ctx.shape[1]
    o = (jnp.einsum('bkgnqj,bnjkd->bnqkgd', p[..., :n_loc].astype(v.dtype), vb)
         + jnp.einsum('bkgnqj,bjkd->bnqkgd', p[..., n_loc:n_loc + n_ctx].astype(v.dtype), v_ctx))
    return o.reshape(B_, L, H * D)


def context_attention(q, k, v, sink):
    B_, L, H, D = q.shape
    KV = k.shape[2]
    G = H // KV
    qg = q.reshape(B_, L, KV, G, D)
    s = jnp.einsum('bqkgd,bjkd->bkgqj', qg, k).astype(jnp.float32) * D ** -0.5
    s_sink = jnp.broadcast_to(sink.astype(jnp.float32).reshape(KV, G)[None, :, :, None, None],
                              s.shape[:-1] + (1,))
    p = jax.nn.softmax(jnp.concatenate([s, s_sink], axis=-1), axis=-1)[..., :-1]
    o = jnp.einsum('bkgqj,bjkd->bqkgd', p.astype(v.dtype), v)
    return o.reshape(B_, L, H * D)


def branch_merge(z, a, b, c, w_br_a, w_br_b, w_br_c, w_out):
    g_a, g_b, g_c = jnp.split(jax.nn.sigmoid(cols(z, COL_GATE, N_BRANCH * D_MODEL)), N_BRANCH, axis=-1)
    merged = g_a * (a @ w_br_a) + g_b * (b @ w_br_b) + g_c * (c @ w_br_c)
    return merged @ w_out


def token_mix(h, hc, need_ctx, w_in, a_v_gain, a_ws, a_bs, b_dw1, b_dw2, b_db, b_norm_g,
              c_q_gain, c_k_gain, c_sink, w_br_a, w_br_b, w_br_c, w_out):
    B_ = h.shape[0]
    z = h @ w_in
    zc = hc @ (w_in if need_ctx else w_in[:, :CTX_STATE_COLS])

    a_out = chunk_spatial_gating(cols(z, COL_AU, A_WIDTH), cols(z, COL_AV, A_WIDTH), a_v_gain, a_ws, a_bs)

    def gla_kvg(zz, hh):
        k = heads(zz, COL_BK, B_KW, B_HEADS, B_DK).astype(jnp.float32)
        v = heads(zz, COL_BV, B_VW, B_HEADS, B_DV).astype(jnp.float32)
        g_f = gla_log_decay(hh, b_dw1[0], b_dw2[0], b_db[0])
        g_b = gla_log_decay(hh, b_dw1[1], b_dw2[1], b_db[1])
        return k, v, g_f, g_b

    k, v, g_f, g_b = gla_kvg(z, h)
    q = heads(z, COL_BQ, B_KW, B_HEADS, B_DK).astype(jnp.float32) * B_DK ** -0.5
    kc, vc, gc_f, gc_b = gla_kvg(zc, hc)
    if need_ctx:
        qc = heads(zc, COL_BQ, B_KW, B_HEADS, B_DK).astype(jnp.float32) * B_DK ** -0.5
        zero = jnp.zeros((B_, B_HEADS, B_DK, B_DV), jnp.float32)
        oc_f, s_f = gla_chunked(qc, kc, vc, gc_f, zero)
        oc_b, s_b = gla_chunked(flip(qc), flip(kc), flip(vc), flip(gc_b), zero)
    else:
        s_f = gla_final_state(kc, vc, gc_f)
        s_b = gla_final_state(flip(kc), flip(vc), flip(gc_b))
    o_f, _ = gla_chunked(q, k, v, g_f, s_f)
    o_b, _ = gla_chunked(flip(q), flip(k), flip(v), flip(g_b), s_b)
    b_out = gla_output(o_f + flip(o_b), cols(z, COL_BG, B_VW), b_norm_g)

    def kv_heads(zz):
        kk = rms_norm(heads(zz, COL_CK, C_KVW, C_KV_HEADS, HEAD_DIM), c_k_gain)
        vv = heads(zz, COL_CV, C_KVW, C_KV_HEADS, HEAD_DIM)
        return kk, vv

    k_att, v_att = kv_heads(z)
    kc_att, vc_att = kv_heads(zc)
    q_att = rope_2d(rms_norm(heads(z, COL_CQ, C_QW, C_HEADS, HEAD_DIM), c_q_gain))
    c_out = window_attention(q_att, rope_2d(k_att), v_att, kc_att, vc_att, c_sink)

    out = branch_merge(z, a_out, b_out, c_out, w_br_a, w_br_b, w_br_c, w_out)
    if not need_ctx:
        return out, None
    ac_out = chunk_spatial_gating(cols(zc, COL_AU, A_WIDTH), cols(zc, COL_AV, A_WIDTH), a_v_gain, a_ws, a_bs)
    bc_out = gla_output(oc_f + flip(oc_b), cols(zc, COL_BG, B_VW), b_norm_g)
    qc_att = rms_norm(heads(zc, COL_CQ, C_QW, C_HEADS, HEAD_DIM), c_q_gain)
    cc_out = context_attention(qc_att, kc_att, vc_att, c_sink)
    out_c = branch_merge(zc, ac_out, bc_out, cc_out, w_br_a, w_br_b, w_br_c, w_out)
    return out, out_c


def setup_inputs(seed: int = 0) -> dict:
    key = jax.random.key(seed)
    ks = jax.random.split(key, 24)
    D = D_MODEL

    def nrm(k, shape, scale):
        return jax.random.normal(k, shape, jnp.float32) * scale

    return {
        'x': nrm(ks[0], (BATCH, SEQ, D), 1.0),
        'c': nrm(ks[1], (BATCH, D), 1.0),
        'ctx': nrm(ks[2], (BATCH, CTX_LEN, D), 1.0),
        'c_ctx': nrm(ks[3], (D,), 1.0),
        'w_ada': nrm(ks[4], (DEPTH, D, N_MOD * D), 0.5 * D ** -0.5),
        'b_ada': nrm(ks[5], (DEPTH, N_MOD * D), 0.02),
        'norm_g': 1.0 + nrm(ks[6], (DEPTH, 3, D), 0.05),
        'w_ffn_up': nrm(ks[7], (DEPTH, 2, D, 2 * FFN_DIM), D ** -0.5),
        'w_ffn_down': nrm(ks[8], (DEPTH, 2, FFN_DIM, D), FFN_DIM ** -0.5),
        'w_in': nrm(ks[9], (DEPTH, D, IN_COLS), D ** -0.5),
        'a_v_gain': 1.0 + nrm(ks[10], (DEPTH, A_WIDTH), 0.05),
        'a_ws': nrm(ks[11], (DEPTH, A_GROUPS, A_CHUNK, A_CHUNK), A_CHUNK ** -0.5),
        'a_bs': 1.0 + nrm(ks[12], (DEPTH, A_GROUPS, A_CHUNK), 0.05),
        'b_decay_w1': nrm(ks[13], (DEPTH, 2, D, B_RANK), D ** -0.5),
        'b_decay_w2': nrm(ks[14], (DEPTH, 2, B_RANK, B_KW), B_RANK ** -0.5),
        'b_decay_b': nrm(ks[15], (DEPTH, 2, B_KW), 0.1),
        'b_norm_g': 1.0 + nrm(ks[16], (DEPTH, B_DV), 0.05),
        'c_q_gain': 1.0 + nrm(ks[17], (DEPTH, HEAD_DIM), 0.05),
        'c_k_gain': 1.0 + nrm(ks[18], (DEPTH, HEAD_DIM), 0.05),
        'c_sink': nrm(ks[19], (DEPTH, C_HEADS), 0.5),
        'w_br_a': nrm(ks[20], (DEPTH, A_WIDTH, D), A_WIDTH ** -0.5),
        'w_br_b': nrm(ks[21], (DEPTH, B_VW, D), B_VW ** -0.5),
        'w_br_c': nrm(ks[22], (DEPTH, C_QW, D), C_QW ** -0.5),
        'w_out': nrm(ks[23], (DEPTH, D, D), D ** -0.5),
    }


def reference(x, c, ctx, c_ctx, w_ada, b_ada, norm_g, w_ffn_up, w_ffn_down, w_in, a_v_gain, a_ws, a_bs,
              b_decay_w1, b_decay_w2, b_decay_b, b_norm_g, c_q_gain, c_k_gain, c_sink,
              w_br_a, w_br_b, w_br_c, w_out):
    D = D_MODEL
    c_act = jax.nn.silu(c)
    cc_act = jax.nn.silu(c_ctx)
    xc = ctx
    for l in range(DEPTH):
        last = l == DEPTH - 1
        m = jnp.split((c_act @ w_ada[l] + b_ada[l])[:, None, :], N_MOD, axis=-1)
        n_c = 5 if last else N_MOD
        mc = jnp.split(cc_act @ w_ada[l][:, :n_c * D] + b_ada[l][:n_c * D], n_c)
        x = x + 0.5 * m[2] * swiglu(modulate(rms_norm(x, norm_g[l, 0]), m[0], m[1]), w_ffn_up[l, 0], w_ffn_down[l, 0])
        xc = xc + 0.5 * mc[2] * swiglu(modulate(rms_norm(xc, norm_g[l, 0]), mc[0], mc[1]), w_ffn_up[l, 0], w_ffn_down[l, 0])
        h = modulate(rms_norm(x, norm_g[l, 1]), m[3], m[4])
        hc = modulate(rms_norm(xc, norm_g[l, 1]), mc[3], mc[4])
        mix, mix_c = token_mix(h, hc, not last, w_in[l], a_v_gain[l], a_ws[l], a_bs[l],
                               b_decay_w1[l], b_decay_w2[l], b_decay_b[l], b_norm_g[l],
                               c_q_gain[l], c_k_gain[l], c_sink[l],
                               w_br_a[l], w_br_b[l], w_br_c[l], w_out[l])
        x = x + m[5] * mix
        x = x + 0.5 * m[8] * swiglu(modulate(rms_norm(x, norm_g[l, 2]), m[6], m[7]), w_ffn_up[l, 1], w_ffn_down[l, 1])
        if not last:
            xc = xc + mc[5] * mix_c
            xc = xc + 0.5 * mc[8] * swiglu(modulate(rms_norm(xc, norm_g[l, 2]), mc[6], mc[7]), w_ffn_up[l, 1], w_ffn_down[l, 1])
    return x
```

```cpp
#include <hip/hip_runtime.h>
#include <cstdio>
#include <cstdint>

#ifndef N_LAUNCH_MODE
#define N_LAUNCH_MODE 1
#endif

#ifndef PROBE_SKIPEPI
#define PROBE_SKIPEPI 0
#endif
namespace pg8 {
#define PG8_LAS __attribute__((address_space(3)))
typedef unsigned short bf16_t;
typedef short bf16x8 __attribute__((ext_vector_type(8)));
typedef float f32x4 __attribute__((ext_vector_type(4)));
typedef unsigned u32x4 __attribute__((ext_vector_type(4)));
typedef unsigned u32x2 __attribute__((ext_vector_type(2)));
constexpr int BM = 256, BK = 64, HALF = 128, HTB = HALF * BK * 2, STAGE_BYTES = 8 * HTB, NXCD = 8, WGM = 8;

__host__ __device__ __forceinline__ int lds_byte(int r, int c) { const int st = (r >> 4) * 2 + (c >> 5), rr = r & 15, cc = c & 31, ob = rr * 64 + cc * 2; return st * 1024 + (ob ^ (((ob >> 9) & 1) << 5)); }
__host__ __device__ __forceinline__ void stage_rc(int b, int& R, int& C) { const int st = b / 1024, sb = b % 1024, swz = sb ^ (((sb >> 9) & 1) << 5); R = (st >> 1) * 16 + swz / 64; C = (st & 1) * 32 + (swz % 64) / 2; }
__host__ __device__ __forceinline__ int perm32(int rho) { const int n = rho >> 4, i = rho & 15; return 8 * (i >> 2) + 4 * n + (i & 3); }

struct Unit { int pm, pn, ks, nt; unsigned koff; };
struct Gemm { const bf16_t* A; const bf16_t* Bt; int lda, ldb; };

struct StaticOrder {
    int nM, nN, nwg, G, c, nt;
    __host__ __device__ void init(int nM_, int nN_, int G_, int c_, int K_) { nM = nM_; nN = nN_; nwg = nM * nN; G = G_; c = c_; nt = K_ / BK; }
    __host__ __device__ bool next(int i, Unit& u) const {
        const long L = (long)i * G + c; if (L >= nwg) return false;
        int wgid = (int)L; { const int q = nwg / NXCD, r = nwg % NXCD, xcd = wgid % NXCD, off = wgid / NXCD; wgid = (xcd < r ? xcd * (q + 1) : r * (q + 1) + (xcd - r) * q) + off; }
        const int nig = WGM * nN, gid = wgid / nig, fm = gid * WGM, gsz = (nM - fm) < WGM ? (nM - fm) : WGM;
        u.pm = fm + ((wgid % nig) % gsz); u.pn = (wgid % nig) / gsz; u.ks = 0; u.koff = 0u; u.nt = nt; return true;
    }
    __device__ __forceinline__ void a_ready(const Unit&) const {}
    __device__ __forceinline__ void done(const Unit&) const {}
};
struct SplitOrder {
    int nM, nN, nS, G, c, K;
    __host__ __device__ void init(int nM_, int nN_, int nS_, int G_, int c_, int K_) { nM = nM_; nN = nN_; nS = nS_; G = G_; c = c_; K = K_; }
    __host__ __device__ bool next(int i, Unit& u) const {
        const long L = (long)i * G + c; if (L >= (long)nM * nN * nS) return false;
        const int x = (int)L; u.ks = x % nS; u.pn = (x / nS) % nN; u.pm = x / (nS * nN); u.koff = (unsigned)(u.ks * K * 2); u.nt = K / BK; return true;
    }
    __device__ __forceinline__ void a_ready(const Unit&) const {}
    __device__ __forceinline__ void done(const Unit&) const {}
};

struct TwoPartOrder {
    StaticOrder L; int nL, nNc, ns, Kc;
    __host__ __device__ void init(int nNl, int Kl, int nNc_, int ns_, int Kc_, int G_, int c_) { L.init(64, nNl, G_, c_, Kl); nL = 64 * nNl; nNc = nNc_; ns = ns_; Kc = Kc_; }
    __host__ __device__ bool next(int i, Unit& u) const {
        const long Lx = (long)i * L.G + L.c;
        if (Lx < nL) return L.next(i, u);
        const int x = (int)(Lx - nL); if (x >= 4 * nNc * ns) return false;
        u.ks = x % ns; u.pn = (x / ns) % nNc; u.pm = 64 + x / (ns * nNc); u.koff = (unsigned)(u.ks * Kc * 2); u.nt = Kc / BK; return true;
    }
    __device__ __forceinline__ void a_ready(const Unit&) const {}
    __device__ __forceinline__ void done(const Unit&) const {}
};
struct MergeOrder {
    StaticOrder T;
    __host__ __device__ void init(int nM_, int nN_, int G_, int c_) { T.init(nM_, nN_, G_, c_, 0); }
    __host__ __device__ bool next(int i, Unit& u) const {
        const int it = i / 3, seg = i - 3 * it;
        if (!T.next(it, u)) return false;
        u.ks = seg; u.koff = seg == 0 ? 0u : (seg == 1 ? 1024u : 2048u); u.nt = seg == 2 ? 16 : 8; return true;
    }
    __device__ __forceinline__ void a_ready(const Unit&) const {}
    __device__ __forceinline__ void done(const Unit&) const {}
};
__device__ __forceinline__ unsigned cvt_pk_bf16(float lo, float hi) { unsigned r; asm volatile("v_cvt_pk_bf16_f32 %0, %1, %2" : "=v"(r) : "v"(lo), "v"(hi)); return r; }
__device__ __forceinline__ float bf_lo(unsigned w) { return __uint_as_float(w << 16); }
__device__ __forceinline__ float bf_hi(unsigned w) { return __uint_as_float(w & 0xffff0000u); }
__device__ __forceinline__ float fast_sigmoid(float x) { return __builtin_amdgcn_rcpf(1.0f + __expf(-x)); }

struct EpiBf16 {
    static constexpr bool PERM = true;
    bf16_t* O; int ldc; int pm_off; int skip; int gate_pn;
    __device__ __forceinline__ void operator()(const f32x4 (&acc)[2][2][4][2], const Unit& u, int wr, int wc, int fr, int fq) const {
        if (PROBE_SKIPEPI && skip) return;
        const int row0 = (u.pm + pm_off) * BM + wr * 64 + fr, col0 = u.pn * BM + wc * 32 + 8 * fq;
        const bool gate = u.pn >= gate_pn;
#pragma unroll
        for (int ai = 0; ai < 2; ++ai)
#pragma unroll
            for (int m = 0; m < 4; ++m) { bf16_t* rowp = O + (size_t)(row0 + ai * HALF + m * 16) * ldc + col0;
#pragma unroll
                for (int bj = 0; bj < 2; ++bj) { f32x4 v0 = acc[ai][bj][m][0], v1 = acc[ai][bj][m][1];
                    if (gate) {
#pragma unroll
                        for (int j = 0; j < 4; ++j) { v0[j] = 1.0f + __expf(-fminf(fmaxf(v0[j], -30.f), 30.f)); v1[j] = 1.0f + __expf(-fminf(fmaxf(v1[j], -30.f), 30.f)); } }
                    u32x4 w; w.x = cvt_pk_bf16(v0[0], v0[1]); w.y = cvt_pk_bf16(v0[2], v0[3]); w.z = cvt_pk_bf16(v1[0], v1[1]); w.w = cvt_pk_bf16(v1[2], v1[3]);
                    *(u32x4*)(rowp + bj * HALF) = w; } }
    }
};
struct EpiUp {
    static constexpr bool PERM = true;
    bf16_t* O; int ldc; int pm_off;
    __device__ __forceinline__ void operator()(const f32x4 (&acc)[2][2][4][2], const Unit& u, int wr, int wc, int fr, int fq) const {
        const int row0 = (u.pm + pm_off) * BM + wr * 64 + fr, col0 = u.pn * HALF + wc * 32 + 8 * fq;
#pragma unroll
        for (int ai = 0; ai < 2; ++ai)
#pragma unroll
            for (int m = 0; m < 4; ++m) { bf16_t* rowp = O + (size_t)(row0 + ai * HALF + m * 16) * ldc + col0;
                f32x4 r0, r1;
#pragma unroll
                for (int j = 0; j < 4; ++j) { const float g0 = acc[ai][0][m][0][j], g1 = acc[ai][0][m][1][j];
                    r0[j] = g0 * fast_sigmoid(g0) * acc[ai][1][m][0][j]; r1[j] = g1 * fast_sigmoid(g1) * acc[ai][1][m][1][j]; }
                u32x4 w; w.x = cvt_pk_bf16(r0[0], r0[1]); w.y = cvt_pk_bf16(r0[2], r0[3]); w.z = cvt_pk_bf16(r1[0], r1[1]); w.w = cvt_pk_bf16(r1[2], r1[3]);
                *(u32x4*)rowp = w; }
    }
};
struct EpiResid {
    static constexpr bool PERM = false;
    const float* xin; float* xout; const float* gate; int gate_stride; float scale;
    __device__ __forceinline__ void operator()(const f32x4 (&acc)[2][2][4][2], const Unit& u, int wr, int wc, int fr, int fq) const {
        if (PROBE_SKIPEPI && scale == 0.f) return;
        const int row0 = u.pm * BM + wr * 64 + fr, col0 = u.pn * BM + wc * 32 + 4 * fq;
        const int bidx = u.pm >> 4;
        f32x4 gv[2][2];
#pragma unroll
        for (int bj = 0; bj < 2; ++bj)
#pragma unroll
            for (int n = 0; n < 2; ++n) gv[bj][n] = *(const f32x4*)(gate + (size_t)bidx * gate_stride + col0 + bj * HALF + n * 16) * scale;
#pragma unroll
        for (int ai = 0; ai < 2; ++ai)
#pragma unroll
            for (int mh = 0; mh < 2; ++mh) { f32x4 xv[2][2][2];
#pragma unroll
                for (int mm = 0; mm < 2; ++mm) { const size_t off = (size_t)(row0 + ai * HALF + (2 * mh + mm) * 16) * 2048 + col0;
#pragma unroll
                    for (int bj = 0; bj < 2; ++bj)
#pragma unroll
                        for (int n = 0; n < 2; ++n) xv[mm][bj][n] = *(const f32x4*)(xin + off + bj * HALF + n * 16); }
#pragma unroll
                for (int mm = 0; mm < 2; ++mm) { const size_t off = (size_t)(row0 + ai * HALF + (2 * mh + mm) * 16) * 2048 + col0;
#pragma unroll
                    for (int bj = 0; bj < 2; ++bj)
#pragma unroll
                        for (int n = 0; n < 2; ++n) *(f32x4*)(xout + off + bj * HALF + n * 16) = xv[mm][bj][n] + gv[bj][n] * acc[ai][bj][2 * mh + mm][n]; } }
    }
};
struct EpiPart {
    static constexpr bool PERM = false;
    float* P;
    __device__ __forceinline__ void operator()(const f32x4 (&acc)[2][2][4][2], const Unit& u, int wr, int wc, int fr, int fq) const {
        const int row0 = u.pm * BM + wr * 64 + fr, col0 = u.pn * BM + wc * 32 + 4 * fq;
        float* base = P + (size_t)u.ks * 1024 * 2048;
#pragma unroll
        for (int ai = 0; ai < 2; ++ai)
#pragma unroll
            for (int m = 0; m < 4; ++m) { float* rowp = base + (size_t)(row0 + ai * HALF + m * 16) * 2048 + col0;
#pragma unroll
                for (int bj = 0; bj < 2; ++bj)
#pragma unroll
                    for (int n = 0; n < 2; ++n) *(f32x4*)(rowp + bj * HALF + n * 16) = acc[ai][bj][m][n]; }
    }
};
struct EpiMergeR {
    static constexpr bool PERM = true;
    const bf16_t* zg; int ldz; bf16_t* O;
    __device__ __forceinline__ bool keep(const Unit& u) const { return u.ks < 2; }
    __device__ __forceinline__ void operator()(f32x4 (&acc)[2][2][4][2], const Unit& u, int wr, int wc, int fr, int fq) const {
        const int row0 = u.pm * BM + wr * 64 + fr, col0 = u.pn * BM + wc * 32 + 8 * fq, seg = u.ks;
        const int cnum = (seg == 0 ? 1 : 2) * 2048, cden = (seg == 0 ? 0 : (seg == 1 ? 1 : 2)) * 2048;
#pragma unroll
        for (int ai = 0; ai < 2; ++ai)
#pragma unroll
            for (int mh = 0; mh < 2; ++mh) { u32x4 zn[2][2], zd[2][2];
#pragma unroll
                for (int mm = 0; mm < 2; ++mm) { const size_t row = (size_t)(row0 + ai * HALF + (2 * mh + mm) * 16);
#pragma unroll
                    for (int bj = 0; bj < 2; ++bj) { zd[mm][bj] = *(const u32x4*)(zg + row * ldz + cden + col0 + bj * HALF);
                        zn[mm][bj] = seg < 2 ? *(const u32x4*)(zg + row * ldz + cnum + col0 + bj * HALF) : (u32x4){0u, 0u, 0u, 0u}; } }
#pragma unroll
                for (int mm = 0; mm < 2; ++mm) { const size_t row = (size_t)(row0 + ai * HALF + (2 * mh + mm) * 16); const int m = 2 * mh + mm;
#pragma unroll
                    for (int bj = 0; bj < 2; ++bj) { const u32x4 d4 = zd[mm][bj], n4 = zn[mm][bj];
                        const float dz[8] = {bf_lo(d4.x), bf_hi(d4.x), bf_lo(d4.y), bf_hi(d4.y), bf_lo(d4.z), bf_hi(d4.z), bf_lo(d4.w), bf_hi(d4.w)};
                        const float nz[8] = {bf_lo(n4.x), bf_hi(n4.x), bf_lo(n4.y), bf_hi(n4.y), bf_lo(n4.z), bf_hi(n4.z), bf_lo(n4.w), bf_hi(n4.w)};
                        float r[8];
#pragma unroll
                        for (int e = 0; e < 8; ++e) { const float num = seg < 2 ? nz[e] : 1.0f; r[e] = num * __builtin_amdgcn_rcpf(dz[e]); }
                        f32x4 v0 = acc[ai][bj][m][0], v1 = acc[ai][bj][m][1];
                        v0[0] *= r[0]; v0[1] *= r[1]; v0[2] *= r[2]; v0[3] *= r[3]; v1[0] *= r[4]; v1[1] *= r[5]; v1[2] *= r[6]; v1[3] *= r[7];
                        if (seg < 2) { acc[ai][bj][m][0] = v0; acc[ai][bj][m][1] = v1; }
                        else { u32x4 w; w.x = cvt_pk_bf16(v0[0], v0[1]); w.y = cvt_pk_bf16(v0[2], v0[3]); w.z = cvt_pk_bf16(v1[0], v1[1]); w.w = cvt_pk_bf16(v1[2], v1[3]);
                            *(u32x4*)(O + row * 2048 + col0 + bj * HALF) = w; } } } }
    }
};
struct EpiResidPart {
    static constexpr bool PERM = false;
    EpiResid R; EpiPart P;
    __device__ __forceinline__ void operator()(const f32x4 (&acc)[2][2][4][2], const Unit& u, int wr, int wc, int fr, int fq) const {
        if (u.pm < 64) R(acc, u, wr, wc, fr, fq); else { Unit v = u; v.pm = u.pm - 64; P(acc, v, wr, wc, fr, fq); }
    }
};
template <class E> __device__ __forceinline__ auto epi_keep(const E& e, const Unit& u, int) -> decltype(e.keep(u)) { return e.keep(u); }
template <class E> __device__ __forceinline__ bool epi_keep(const E&, const Unit&, long) { return false; }
template <class Epi, class Sched, bool ALIGN_EPI = true>
__device__ __forceinline__ void gemm_phase(PG8_LAS unsigned char* lds, const Gemm g, const Sched& S, const Epi& E) {
    int tid_ = threadIdx.x; asm volatile("" : "+v"(tid_));
    const int tid = tid_, wid = __builtin_amdgcn_readfirstlane(tid >> 6), lane = tid & 63, wr = wid >> 2, wc = wid & 3, fr = lane & 15, fq = lane >> 4;
    unsigned voffA[2], voffB[2];
#pragma unroll
    for (int i = 0; i < 2; ++i) { int R, C; stage_rc(tid * 16 + i * 8192, R, C); const int Rb = Epi::PERM ? ((R & ~31) + perm32(R & 31)) : R;
        voffA[i] = (unsigned)(R * g.lda + C) * 2u; voffB[i] = (unsigned)(Rb * g.ldb + C) * 2u; }
    const size_t kstep = (size_t)(BK * 2);
    const size_t hA = (size_t)HALF * g.lda * 2, hB = (size_t)HALF * g.ldb * 2;
    const size_t tA = 2 * hA, tB = 2 * hB;
    const unsigned ldsw = (unsigned)wid * 1024u;
    const int aoff = lds_byte(wr * 64 + fr, fq * 8), boff = lds_byte(wc * 32 + fr, fq * 8);
#define PG8_SA(b, h) (((b) * 2 + (h)) * HTB)
#define PG8_SB(b, h) ((4 + (b) * 2 + (h)) * HTB)
#define PG8_STAGE(bufoff, gbase, voff) do { _Pragma("unroll") for (int _i = 0; _i < 2; ++_i) \
        __builtin_amdgcn_global_load_lds((const unsigned*)((const char*)(gbase) + (voff)[_i]), (PG8_LAS unsigned*)(lds + (bufoff) + ldsw + _i * 8192), 16, 0, 0); } while (0)
#define PG8_LDA(dst, b, h) do { _Pragma("unroll") for (int m = 0; m < 4; ++m) _Pragma("unroll") for (int k = 0; k < 2; ++k) dst[m][k] = *(const PG8_LAS bf16x8*)(lds + PG8_SA(b, h) + aoff + m * 2048 + k * 1024); } while (0)
#define PG8_LDB(dst, b, h) do { _Pragma("unroll") for (int n = 0; n < 2; ++n) _Pragma("unroll") for (int k = 0; k < 2; ++k) dst[n][k] = *(const PG8_LAS bf16x8*)(lds + PG8_SB(b, h) + boff + n * 2048 + k * 1024); } while (0)
#define PG8_MMA(ai, bj, At, Bt) do { __builtin_amdgcn_s_setprio(1); _Pragma("unroll") for (int m = 0; m < 4; ++m) _Pragma("unroll") for (int n = 0; n < 2; ++n) _Pragma("unroll") for (int k = 0; k < 2; ++k) \
        acc[ai][bj][m][n] = __builtin_amdgcn_mfma_f32_16x16x32_bf16(Bt[n][k], At[m][k], acc[ai][bj][m][n], 0, 0, 0); __builtin_amdgcn_s_setprio(0); } while (0)
#define PG8_WAIT_V(n) asm volatile("s_waitcnt vmcnt(" #n ")" ::: "memory")
#define PG8_WAIT_L(n) asm volatile("s_waitcnt lgkmcnt(" #n ")" ::: "memory")
#define PG8_BAR __builtin_amdgcn_s_barrier()
#define PG8_SCHED __builtin_amdgcn_sched_barrier(0)
    Unit cur, nxt; int ui = 0;
    if (!S.next(0, cur)) return;
    f32x4 acc[2][2][4][2];
#pragma unroll
    for (int a = 0; a < 2; ++a)
#pragma unroll
        for (int b = 0; b < 2; ++b)
#pragma unroll
            for (int m = 0; m < 4; ++m)
#pragma unroll
                for (int n = 0; n < 2; ++n) acc[a][b][m][n] = (f32x4){0.f, 0.f, 0.f, 0.f};
    bf16x8 At[4][2], B0[2][2], B1[2][2];
    const char* cA = (const char*)g.A + (size_t)cur.pm * tA + cur.koff; const char* cB = (const char*)g.Bt + (size_t)cur.pn * tB + cur.koff;
    S.a_ready(cur);
    PG8_STAGE(PG8_SB(0, 0), cB, voffB); PG8_STAGE(PG8_SB(0, 1), cB + hB, voffB); PG8_STAGE(PG8_SA(0, 0), cA, voffA); PG8_STAGE(PG8_SA(0, 1), cA + hA, voffA);
    if (wr == 1) PG8_BAR;
    PG8_WAIT_V(2); PG8_BAR;
    PG8_STAGE(PG8_SB(1, 0), cB + kstep, voffB); PG8_STAGE(PG8_SA(1, 0), cA + kstep, voffA); PG8_STAGE(PG8_SB(1, 1), cB + hB + kstep, voffB);
    PG8_WAIT_V(6); PG8_BAR;
    for (;;) {
        const bool has_next = S.next(ui + 1, nxt);
        const char* nA = has_next ? (const char*)g.A + (size_t)nxt.pm * tA + nxt.koff : cA; const char* nB = has_next ? (const char*)g.Bt + (size_t)nxt.pn * tB + nxt.koff : cB;
        const int nt = cur.nt;
        for (int t = 0; t < nt; t += 2) {
            const bool last = (t == nt - 2);
            const char* a1 = cA + (size_t)(t + 1) * kstep;
            const char* a2 = last ? nA : cA + (size_t)(t + 2) * kstep; const char* b2 = last ? nB : cB + (size_t)(t + 2) * kstep;
            const char* a3 = a2 + kstep; const char* b3 = b2 + kstep;
            if (last && has_next) S.a_ready(nxt);
            PG8_LDB(B0, 0, 0); PG8_LDB(B1, 0, 1); PG8_SCHED; PG8_LDA(At, 0, 0); PG8_STAGE(PG8_SA(1, 1), a1 + hA, voffA);
            PG8_WAIT_V(8); PG8_WAIT_L(0); PG8_BAR; PG8_MMA(0, 0, At, B0); PG8_MMA(0, 1, At, B1); PG8_BAR; PG8_SCHED;
            PG8_LDA(At, 0, 1); PG8_STAGE(PG8_SB(0, 0), b2, voffB); PG8_STAGE(PG8_SB(0, 1), b2 + hB, voffB); PG8_STAGE(PG8_SA(0, 0), a2, voffA);
            PG8_WAIT_V(8); PG8_WAIT_L(0); PG8_BAR; PG8_MMA(1, 0, At, B0); PG8_MMA(1, 1, At, B1); PG8_BAR; PG8_SCHED;
            PG8_LDB(B0, 1, 0); PG8_LDB(B1, 1, 1); PG8_SCHED; PG8_LDA(At, 1, 0); PG8_STAGE(PG8_SA(0, 1), a2 + hA, voffA);
            PG8_WAIT_V(8); PG8_WAIT_L(0); PG8_BAR; PG8_MMA(0, 0, At, B0); PG8_MMA(0, 1, At, B1); PG8_BAR; PG8_SCHED;
            PG8_LDA(At, 1, 1); PG8_STAGE(PG8_SB(1, 0), b3, voffB); PG8_STAGE(PG8_SB(1, 1), b3 + hB, voffB); PG8_STAGE(PG8_SA(1, 0), a3, voffA);
            PG8_WAIT_V(8); PG8_WAIT_L(0); PG8_BAR; PG8_MMA(1, 0, At, B0); PG8_MMA(1, 1, At, B1); PG8_BAR; PG8_SCHED;
        }
        if constexpr (ALIGN_EPI) { if (wr == 0) PG8_BAR; }
        E(acc, cur, wr, wc, fr, fq); S.done(cur);
        if (!has_next) break;
        if (!epi_keep(E, cur, 0)) {
#pragma unroll
        for (int a = 0; a < 2; ++a)
#pragma unroll
            for (int b = 0; b < 2; ++b)
#pragma unroll
                for (int m = 0; m < 4; ++m)
#pragma unroll
                    for (int n = 0; n < 2; ++n) acc[a][b][m][n] = (f32x4){0.f, 0.f, 0.f, 0.f};
        }
        cur = nxt; cA = nA; cB = nB; ++ui;
        if constexpr (ALIGN_EPI) { if (wr == 1) PG8_BAR; }
    }
    PG8_WAIT_V(0);
    if constexpr (!ALIGN_EPI) { if (wr == 0) PG8_BAR; }
    PG8_BAR;
#undef PG8_SA
#undef PG8_SB
#undef PG8_STAGE
#undef PG8_LDA
#undef PG8_LDB
#undef PG8_MMA
#undef PG8_WAIT_V
#undef PG8_WAIT_L
#undef PG8_BAR
#undef PG8_SCHED
}
}

constexpr int NWAVES = 8;
constexpr int D = 2048, BATCH = 4, SEQ = 4096, CTXL = 256, FFN = 5632, INC = 10240, NMOD = 9;
constexpr int ML = BATCH * SEQ, MC = BATCH * CTXL, MT = ML + MC;
constexpr int COL_BK = 0, COL_BV = 256, COL_CK = 768, COL_CV = 1024, COL_AU = 1280, COL_AV = 1792, COL_BQ = 2304, COL_BG = 2560, COL_CQ = 3072, COL_GATE = 4096;
constexpr float EPS = 1e-6f;

constexpr size_t MiB = 1u << 20;
constexpr size_t al(size_t x) { return (x + 4095) & ~(size_t)4095; }
constexpr size_t WS_CTL = 0, CTL_ZERO_BYTES = 1 * MiB;
constexpr size_t WS_MOD = 1 * MiB;
constexpr size_t WS_W = 2 * MiB;
constexpr size_t W_UP_E = (size_t)2 * FFN * D, W_DN_E = (size_t)D * FFN, W_IN_E = (size_t)INC * D, W_BRA_E = (size_t)D * 512, W_BRC_E = (size_t)D * 1024, W_OUT_E = (size_t)D * D, W_LR_E = (size_t)256 * D;
constexpr size_t WO_UP = 0, WO_DN = WO_UP + 2 * W_UP_E, WO_IN = WO_DN + 2 * W_DN_E, WO_BRA = WO_IN + W_IN_E, WO_BRB = WO_BRA + W_BRA_E, WO_BRC = WO_BRB + W_BRA_E, WO_OUT = WO_BRC + W_BRC_E, WO_LR = WO_OUT + W_OUT_E,
                 W_LAYER_E = WO_LR + W_LR_E;
constexpr size_t WS_XBUF = al(WS_W + 2 * W_LAYER_E * 2);
constexpr size_t WS_HA = al(WS_XBUF + (size_t)MT * D * 4);
constexpr size_t WS_ABC = al(WS_HA + (size_t)MT * D * 2);
constexpr size_t WS_Z = al(WS_ABC + (size_t)MT * D * 2);
constexpr size_t WS_MIX = al(WS_Z + (size_t)MT * INC * 2);
constexpr size_t WS_QN = WS_MIX;
constexpr size_t WS_KN = al(WS_QN + (size_t)MT * 1024 * 2);
constexpr size_t WS_VN = al(WS_KN + (size_t)MT * 256 * 2);
constexpr size_t WS_LR = al(WS_VN + (size_t)MT * 512 * 2);
constexpr size_t WS_ST = al(WS_LR + (size_t)MT * 32 * 4);
constexpr size_t WS_DEC = al(WS_ST + (size_t)32 * 68 * 8192 * 4);
constexpr size_t WS_MIX_USED = al(WS_DEC + (size_t)32 * 68 * 64 * 4);
constexpr size_t WS_MIX_END = (WS_MIX_USED > WS_MIX + (size_t)MT * D * 4) ? WS_MIX_USED : al(WS_MIX + (size_t)MT * D * 4);
constexpr size_t WS_MERGEF = WS_MIX;
static_assert(WS_MERGEF + (size_t)MT * D * 4 <= WS_MIX_END, "MERGEF overlay");
constexpr size_t WS_PART = WS_MIX_END;
constexpr size_t WS_END = WS_PART + (size_t)8 * MC * D * 4;
static_assert(WS_END <= (size_t)1476395008, "workspace map exceeds the guaranteed d_ws size");
constexpr int CW_BAR = 4096;

constexpr int RING_OFF = 0, RING_BYTES = 131072;
constexpr int LDS_BYTES = 147456;
constexpr int LDSCTL_OFF = LDS_BYTES - 512, MISC_OFF = LDSCTL_OFF + 320;

#define GAS __attribute__((address_space(1)))
#define LAS __attribute__((address_space(3)))
typedef unsigned short bf16;
typedef unsigned v4u __attribute__((ext_vector_type(4)));
typedef unsigned v2u __attribute__((ext_vector_type(2)));
typedef float f32x4 __attribute__((ext_vector_type(4)));
typedef short bf16x8 __attribute__((ext_vector_type(8)));
typedef short s16x4 __attribute__((ext_vector_type(4)));
#define MFMA16(a, b, c) __builtin_amdgcn_mfma_f32_16x16x32_bf16((a), (b), (c), 0, 0, 0)
#define LDS_WAIT() asm volatile("s_waitcnt lgkmcnt(0)" ::: "memory")
#define VM_WAIT() asm volatile("s_waitcnt vmcnt(0)" ::: "memory")
__device__ __forceinline__ unsigned f2bf(float f) { unsigned u = __builtin_bit_cast(unsigned, f); return (u + 0x7fffu + ((u >> 16) & 1u)) >> 16; }
__device__ __forceinline__ unsigned pk2(float lo, float hi) { return f2bf(lo) | (f2bf(hi) << 16); }
__device__ __forceinline__ float bf2f(bf16 b) { return __uint_as_float(((unsigned)b) << 16); }
__device__ __forceinline__ float blo(unsigned w) { return __uint_as_float(w << 16); }
__device__ __forceinline__ float bhi(unsigned w) { return __uint_as_float(w & 0xffff0000u); }
__device__ __forceinline__ float wave_sum(float v) {
#pragma unroll
    for (int o = 1; o < 64; o <<= 1) v += __shfl_xor(v, o);
    return v;
}
__device__ __forceinline__ float wave_max(float v) {
#pragma unroll
    for (int o = 1; o < 64; o <<= 1) v = fmaxf(v, __shfl_xor(v, o));
    return v;
}
__device__ __forceinline__ float silu_f(float x) { return x / (1.0f + __expf(-x)); }
__device__ __forceinline__ float gelu_tanh(float x) { const float u = 1.5957691216057308f * (x + 0.044715f * x * x * x); return x * __builtin_amdgcn_rcpf(1.0f + __expf(-u)); }
__device__ __forceinline__ float log_sigmoid(float x) { return fminf(x, 0.f) - __logf(1.0f + __expf(-fabsf(x))); }

#define XB_TMO      128
#define XB_XCNT(j)  (256  + 64 * (j))
#define XB_XSUB(j)  (1280 + 64 * (j))
#define XB_XGEN(j)  (2304 + 64 * (j))
#define XB_TOP      3328
#define XB_TOPGEN   3392
#define XCD_BAR_WORDS 3456
#define XB_SPIN_CAP (1u << 18)
__device__ __forceinline__ unsigned xb_ld(unsigned* p)              { return __hip_atomic_load(p, __ATOMIC_RELAXED, __HIP_MEMORY_SCOPE_AGENT); }
__device__ __forceinline__ unsigned xb_add(unsigned* p, unsigned v) { return __hip_atomic_fetch_add(p, v, __ATOMIC_RELAXED, __HIP_MEMORY_SCOPE_AGENT); }
__device__ __forceinline__ unsigned xb_xcc_id() { return (unsigned)__builtin_amdgcn_s_getreg((3 << 11) | 20) & 0xFu; }
#define XB_SPIN(cond, bar) do { unsigned _sp = 0; while (cond) { __builtin_amdgcn_s_sleep(1); \
    if ((++_sp & 255u) == 0u) { if (xb_ld(&(bar)[XB_TMO])) break; if (_sp > XB_SPIN_CAP) { atomicAdd(&(bar)[XB_TMO], 1u); break; } } } } while (0)
struct XcdBarrier { unsigned* bar; unsigned x; volatile LAS unsigned* st; };
__device__ __forceinline__ XcdBarrier xcd_barrier_post(unsigned* bar, volatile LAS unsigned* st) {
    XcdBarrier b; b.bar = bar; b.x = xb_xcc_id(); b.st = st;
    if (threadIdx.x == 0) (void)xb_add(&bar[XB_XCNT(b.x)], 1u);
    return b;
}
__device__ __forceinline__ void xcd_barrier_complete(unsigned* bar, unsigned x, unsigned& nloc, unsigned& nx) {
    const unsigned G = gridDim.x * gridDim.y * gridDim.z;
    unsigned sum, cnt, mine, sp = 0u;
    for (;;) {
        sum = 0u; cnt = 0u; mine = 0u;
#pragma unroll
        for (unsigned j = 0; j < 16; ++j) { const unsigned c = xb_ld(&bar[XB_XCNT(j)]); sum += c; cnt += (c > 0u) ? 1u : 0u; mine = (j == x) ? c : mine; }
        if (sum == G) break;
        __builtin_amdgcn_s_sleep(1);
        if ((++sp & 255u) == 0u) { if (xb_ld(&bar[XB_TMO])) break; if (sp > XB_SPIN_CAP) { atomicAdd(&bar[XB_TMO], 1u); break; } }
    }
    nloc = mine > 0u ? mine : 1u; nx = cnt > 0u ? cnt : 1u;
}
__device__ __forceinline__ void xcd_barrier(const XcdBarrier& b) {
    asm volatile("s_waitcnt vmcnt(0)" ::: "memory");
    __syncthreads();
    if (threadIdx.x == 0) {
        unsigned* bar = b.bar;
        __builtin_amdgcn_s_waitcnt(0);
        unsigned nloc = b.st[0], nx = b.st[1];
        if (nloc == 0u) { xcd_barrier_complete(bar, b.x, nloc, nx); b.st[0] = nloc; b.st[1] = nx; }
        const unsigned old = xb_add(&bar[XB_XSUB(b.x)], 1u);
        const unsigned gen = old / nloc;
        if (old + 1u == (gen + 1u) * nloc) {
            __builtin_amdgcn_fence(__ATOMIC_RELEASE, "agent");
            asm volatile("s_waitcnt vmcnt(0)" ::: "memory");
            const unsigned og = xb_add(&bar[XB_TOP], 1u);
            const unsigned tg = og / nx;
            if (og + 1u == (tg + 1u) * nx) xb_add(&bar[XB_TOPGEN], 1u);
            else XB_SPIN(xb_ld(&bar[XB_TOPGEN]) == tg, bar);
            __builtin_amdgcn_fence(__ATOMIC_ACQUIRE, "agent");
            xb_add(&bar[XB_XGEN(b.x)], 1u);
            asm volatile("s_waitcnt vmcnt(0)" ::: "memory");
        } else {
            XB_SPIN(xb_ld(&bar[XB_XGEN(b.x)]) == gen, bar);
            __builtin_amdgcn_fence(__ATOMIC_ACQUIRE, "agent");
            asm volatile("s_waitcnt vmcnt(0)" ::: "memory");
        }
    }
    __syncthreads();
}

struct Frame {
    LAS unsigned char* lds;
    int tid, lane, wave, G, gw, ngw;
    unsigned char* ws;
};
struct Args { const float* in[24]; float* out; unsigned char* ws; int ph_lo, ph_hi; };
#define WSP(T, off) ((T*)(F.ws + (off)))
__device__ __forceinline__ bf16* wptr(const Frame& F, int l, size_t off) { return (bf16*)(F.ws + WS_W) + (size_t)l * W_LAYER_E + off; }
__device__ __forceinline__ const float* modp(const Frame& F, int l, int bidx, int k) { return (const float*)(F.ws + WS_MOD) + ((size_t)(l * 5 + bidx) * NMOD + k) * D; }

__device__ __forceinline__ int opqv(int v) { asm volatile("" : "+v"(v)); return v; }
__device__ __forceinline__ int opqs(int v) { asm volatile("" : "+s"(v)); return v; }
#define PH_IDS const int tid = opqv(F.tid), lane = tid & 63, wave = opqs(F.wave), gw = blockIdx.x * NWAVES + wave, ngw = F.G * NWAVES; (void)tid; (void)lane; (void)wave; (void)gw; (void)ngw
__device__ __forceinline__ void transpose_item(const float* W, int N, int ldk, bf16* WT, int k0, int nsrc0, int ndst0, LAS float* scr, int lane) {
#pragma unroll 8
    for (int i = 0; i < 32; ++i) { const int kk = 2 * i + (lane >> 5); scr[kk * 33 + (lane & 31)] = W[(size_t)(k0 + kk) * N + nsrc0 + (lane & 31)]; }
    LDS_WAIT(); asm volatile("" ::: "memory");
    const int c = lane & 7;
#pragma unroll
    for (int j = 0; j < 4; ++j) { const int n = (lane >> 3) + 8 * j; const LAS float* s = scr + (8 * c) * 33 + n;
        v4u o; o.x = pk2(s[0 * 33], s[1 * 33]); o.y = pk2(s[2 * 33], s[3 * 33]); o.z = pk2(s[4 * 33], s[5 * 33]); o.w = pk2(s[6 * 33], s[7 * 33]);
        *(v4u*)(WT + (size_t)(ndst0 + n) * ldk + k0 + 8 * c) = o; }
    LDS_WAIT(); asm volatile("" ::: "memory");
}
__device__ __forceinline__ void phase_prologue(const Args& args, Frame& F) {
    PH_IDS;
    LAS float* scr = (LAS float*)(F.lds + wave * 16384);
    constexpr int I_UP = 32 * 352, I_DN = 88 * 64, I_IN = 32 * 320, I_BA = 8 * 64, I_BC = 16 * 64, I_OUT = 32 * 64;
    constexpr int I_LAYER = 2 * I_UP + 2 * I_DN + I_IN + 2 * I_BA + I_BC + I_OUT;
    for (int it = gw; it < 2 * I_LAYER; it += ngw) {
        const int l = it / I_LAYER; int r = it % I_LAYER;
        const float* src; bf16* dst; int N, K; bool up = false; int ldk = 0;
        if (r < 2 * I_UP) { const int f = r / I_UP; r %= I_UP; src = args.in[7] + (size_t)(l * 2 + f) * D * 2 * FFN; dst = wptr(F, l, WO_UP + f * W_UP_E); N = 2 * FFN; K = D; up = true; }
        else if ((r -= 2 * I_UP) < 2 * I_DN) { const int f = r / I_DN; r %= I_DN; src = args.in[8] + (size_t)(l * 2 + f) * FFN * D; dst = wptr(F, l, WO_DN + f * W_DN_E); N = D; K = FFN; }
        else if ((r -= 2 * I_DN) < I_IN) { src = args.in[9] + (size_t)l * D * INC; dst = wptr(F, l, WO_IN); N = INC; K = D; }
        else if ((r -= I_IN) < I_BA) { src = args.in[20] + (size_t)l * 512 * D; dst = wptr(F, l, WO_BRA); N = D; K = 512; ldk = D; }
        else if ((r -= I_BA) < I_BA) { src = args.in[21] + (size_t)l * 512 * D; dst = wptr(F, l, WO_BRA) + 512; N = D; K = 512; ldk = D; }
        else if ((r -= I_BA) < I_BC) { src = args.in[22] + (size_t)l * 1024 * D; dst = wptr(F, l, WO_BRA) + 1024; N = D; K = 1024; ldk = D; }
        else { r -= I_BC; src = args.in[23] + (size_t)l * D * D; dst = wptr(F, l, WO_OUT); N = D; K = D; }
        const int nblk = N / 32, kb = r / nblk, nb = r % nblk, ndst0 = 32 * nb;
        int nsrc0 = ndst0;
        if (up) { const int pn = ndst0 >> 8, w = ndst0 & 255; nsrc0 = (w >> 7) * FFN + 128 * pn + (w & 127); }
        transpose_item(src, N, ldk ? ldk : K, dst, 64 * kb, nsrc0, ndst0, scr, lane);
    }
    for (int l = 0; l < 2; ++l) {
        bf16* dst = wptr(F, l, WO_LR); const float* w1 = args.in[13] + (size_t)l * 2 * D * 16;
        for (int i = blockIdx.x * 512 + tid; i < 32 * D; i += F.G * 512) { const int n = i / D, k = i % D;
            dst[i] = (bf16)f2bf(w1[((size_t)(n >> 4) * D + k) * 16 + (n & 15)]); }
    }
    __syncthreads();
    LAS float* cact = (LAS float*)F.lds;
    LAS float* red = (LAS float*)(F.lds + 40960);
    for (int i = tid; i < 5 * D; i += 512) { const int b = i / D, k = i % D; const float v = b < 4 ? args.in[1][b * D + k] : args.in[3][k]; cact[i] = silu_f(v); }
    __syncthreads();
    for (int u = blockIdx.x; u < 256; u += F.G) {
        const int l = u >> 7, cb = (u & 127) * 144;
        if (tid < 504) {
            const int cg = tid % 36, ks = tid / 36, k0 = ks * 147, k1 = (k0 + 147) < D ? (k0 + 147) : D;
            f32x4 a0 = {0, 0, 0, 0}, a1 = a0, a2 = a0, a3 = a0, a4 = a0;
            const float* wp = args.in[4] + (size_t)l * D * (NMOD * D) + cb + cg * 4;
#pragma unroll 4
            for (int k = k0; k < k1; ++k) { const f32x4 w = *(const f32x4*)(wp + (size_t)k * (NMOD * D));
                a0 += cact[k] * w; a1 += cact[D + k] * w; a2 += cact[2 * D + k] * w; a3 += cact[3 * D + k] * w; a4 += cact[4 * D + k] * w; }
            LAS float* rp = red + ks * 720 + cg * 4;
#pragma unroll
            for (int j = 0; j < 4; ++j) { rp[j] = a0[j]; rp[144 + j] = a1[j]; rp[288 + j] = a2[j]; rp[432 + j] = a3[j]; rp[576 + j] = a4[j]; }
        }
        __syncthreads();
        for (int idx = tid; idx < 720; idx += 512) { const int i = idx / 144, cc = idx % 144; float s = 0.f;
#pragma unroll
            for (int ks = 0; ks < 14; ++ks) s += red[ks * 720 + idx];
            s += args.in[5][(size_t)l * NMOD * D + cb + cc];
            ((float*)(F.ws + WS_MOD))[(size_t)(l * 5 + i) * NMOD * D + cb + cc] = s; }
        __syncthreads();
    }
}

template <int NS> __device__ __forceinline__ void phase_norm(const Args& args, Frame& F, int l, int which, bool first, int nrows, const float* pgate, float pscale) {
    PH_IDS;
    float* xbuf = WSP(float, WS_XBUF); bf16* HA = WSP(bf16, WS_HA);
    const float* gain = args.in[6] + (size_t)(l * 3 + which) * D;
    for (int row = gw; row < nrows; row += ngw) {
        const float* src = first ? (row < ML ? args.in[0] + (size_t)row * D : args.in[2] + (size_t)(row - ML) * D) : xbuf + (size_t)row * D;
        const int bidx = row < ML ? (row >> 12) : 4;
        const float* sh = modp(F, l, bidx, 3 * which), * sc = modp(F, l, bidx, 3 * which + 1);
        f32x4 v[8]; float ss = 0.f;
#pragma unroll
        for (int j = 0; j < 8; ++j) v[j] = ((const f32x4*)src)[lane + 64 * j];
        const bool upd = (pgate != nullptr) && row >= ML;
        if (upd) { const float* pp = WSP(float, WS_PART) + (size_t)(row - ML) * D;
#pragma unroll
            for (int j = 0; j < 8; ++j) { f32x4 pa[NS];
#pragma unroll
                for (int ks = 0; ks < NS; ++ks) pa[ks] = ((const f32x4*)(pp + (size_t)ks * MC * D))[lane + 64 * j];
                f32x4 a = pa[0];
#pragma unroll
                for (int ks = 1; ks < NS; ++ks) a += pa[ks];
                v[j] += pscale * ((const f32x4*)pgate)[lane + 64 * j] * a; } }
#pragma unroll
        for (int j = 0; j < 8; ++j) ss += (v[j].x * v[j].x + v[j].y * v[j].y) + (v[j].z * v[j].z + v[j].w * v[j].w);
        const float rstd = rsqrtf(wave_sum(ss) * (1.f / D) + EPS);
        if ((first && row >= ML) || upd) {
#pragma unroll
            for (int j = 0; j < 8; ++j) ((f32x4*)(xbuf + (size_t)row * D))[lane + 64 * j] = v[j];
        }
#pragma unroll
        for (int j = 0; j < 8; ++j) { const int c4 = lane + 64 * j;
            const f32x4 g = ((const f32x4*)gain)[c4], s1 = ((const f32x4*)sc)[c4], s0 = ((const f32x4*)sh)[c4];
            const f32x4 h = v[j] * rstd * g * (1.f + s1) + s0;
            v2u o; o.x = pk2(h.x, h.y); o.y = pk2(h.z, h.w);
            ((v2u*)(HA + (size_t)row * D))[c4] = o; }
    }
}

__device__ __forceinline__ void lr_block(const Args& args, Frame& F, int l, int rb) {
    PH_IDS;
    const bf16* HA = WSP(bf16, WS_HA); const bf16* W = wptr(F, l, WO_LR); float* LR = WSP(float, WS_LR);
    const int fr = lane & 15, fq = lane >> 4, k0 = 256 * wave;
    f32x4 acc[4][2];
#pragma unroll
    for (int mt = 0; mt < 4; ++mt) { acc[mt][0] = (f32x4){0.f, 0.f, 0.f, 0.f}; acc[mt][1] = acc[mt][0]; }
#pragma unroll 2
    for (int ks = 0; ks < 8; ++ks) { const int k = k0 + 32 * ks + 8 * fq;
        const bf16x8 b0 = *(const bf16x8*)(W + (size_t)fr * D + k), b1 = *(const bf16x8*)(W + (size_t)(16 + fr) * D + k);
#pragma unroll
        for (int mt = 0; mt < 4; ++mt) { const bf16x8 a = *(const bf16x8*)(HA + (size_t)(64 * rb + 16 * mt + fr) * D + k);
            acc[mt][0] = MFMA16(b0, a, acc[mt][0]); acc[mt][1] = MFMA16(b1, a, acc[mt][1]); } }
    LAS float* part = (LAS float*)F.lds;
#pragma unroll
    for (int mt = 0; mt < 4; ++mt)
#pragma unroll
        for (int nt = 0; nt < 2; ++nt) *(LAS f32x4*)(part + wave * 2048 + (16 * mt + fr) * 32 + 16 * nt + 4 * fq) = acc[mt][nt];
    __syncthreads();
    { f32x4 a = *(const LAS f32x4*)(part + tid * 4);
#pragma unroll
      for (int w = 1; w < 8; ++w) a += *(const LAS f32x4*)(part + w * 2048 + tid * 4);
      *(f32x4*)(LR + (size_t)64 * rb * 32 + tid * 4) = a; }
    __syncthreads();
}

__device__ __forceinline__ void phase_prep(const Args& args, Frame& F, int l) {
    PH_IDS;
    const bf16* Z = WSP(bf16, WS_Z); bf16* QN = WSP(bf16, WS_QN); bf16* KN = WSP(bf16, WS_KN); bf16* VN = WSP(bf16, WS_VN);
    const float* qg = args.in[17] + l * 128, * kg = args.in[18] + l * 128, * avg = args.in[10] + l * 512;
    const int hsel = lane >> 5, j5 = lane & 31, hs = j5 >> 4, f0 = (j5 & 15) * 2;
    const int d1 = hs * 64 + f0, d2 = d1 + 32;
    const float invf0 = __powf(10000.f, -(float)f0 * (1.f / 32.f)), invf1 = __powf(10000.f, -(float)(f0 + 1) * (1.f / 32.f));
    const float gq1a = qg[d1], gq1b = qg[d1 + 1], gq2a = qg[d2], gq2b = qg[d2 + 1], gk1a = kg[d1], gk1b = kg[d1 + 1], gk2a = kg[d2], gk2b = kg[d2 + 1];
    unsigned nu1[5], nu2[5]; v4u nraw;
#define PREP_LOAD(r) do { const bf16* _z = Z + (size_t)(r) * INC; _Pragma("unroll") for (int it = 0; it < 5; ++it) { const bf16* _s = it < 4 ? _z + COL_CQ + (2 * it + hsel) * 128 : _z + COL_CK + hsel * 128; \
        nu1[it] = *(const unsigned*)(_s + d1); nu2[it] = *(const unsigned*)(_s + d2); } nraw = *(const v4u*)(_z + COL_AV + lane * 8); } while (0)
    if (gw < MT) PREP_LOAD(gw);
    for (int row = gw; row < MT; row += ngw) {
        unsigned u1[5], u2[5];
#pragma unroll
        for (int it = 0; it < 5; ++it) { u1[it] = nu1[it]; u2[it] = nu2[it]; }
        const v4u raw = nraw;
        if (row + ngw < MT) PREP_LOAD(row + ngw);
        float cs0 = 1.f, sn0 = 0.f, cs1 = 1.f, sn1 = 0.f;
        if (row < ML) { const int t = row & 4095; const float pos = (float)(hs ? (t & 63) : (t >> 6)); cs0 = __cosf(pos * invf0); sn0 = __sinf(pos * invf0); cs1 = __cosf(pos * invf1); sn1 = __sinf(pos * invf1); }
#pragma unroll
        for (int it = 0; it < 5; ++it) {
            const float x1a = blo(u1[it]), x1b = bhi(u1[it]), x2a = blo(u2[it]), x2b = bhi(u2[it]);
            float ss = (x1a * x1a + x1b * x1b) + (x2a * x2a + x2b * x2b);
            ss += __shfl_xor(ss, 1); ss += __shfl_xor(ss, 2); ss += __shfl_xor(ss, 4); ss += __shfl_xor(ss, 8); ss += __shfl_xor(ss, 16);
            const float rstd = rsqrtf(ss * (1.f / 128.f) + EPS);
            const float y1a = x1a * rstd * (it < 4 ? gq1a : gk1a), y1b = x1b * rstd * (it < 4 ? gq1b : gk1b), y2a = x2a * rstd * (it < 4 ? gq2a : gk2a), y2b = x2b * rstd * (it < 4 ? gq2b : gk2b);
            float o1a = y1a * cs0 - y2a * sn0, o2a = y1a * sn0 + y2a * cs0, o1b = y1b * cs1 - y2b * sn1, o2b = y1b * sn1 + y2b * cs1;
            if (it < 4) { o1a *= 0.12751743074602112f; o2a *= 0.12751743074602112f; o1b *= 0.12751743074602112f; o2b *= 0.12751743074602112f; }
            bf16* dst = it < 4 ? QN + (size_t)row * 1024 + (2 * it + hsel) * 128 : KN + (size_t)row * 256 + hsel * 128;
            *(unsigned*)(dst + d1) = pg8::cvt_pk_bf16(o1a, o1b); *(unsigned*)(dst + d2) = pg8::cvt_pk_bf16(o2a, o2b);
        }
        {
            float e[8] = {blo(raw.x), bhi(raw.x), blo(raw.y), bhi(raw.y), blo(raw.z), bhi(raw.z), blo(raw.w), bhi(raw.w)};
            float s = 0.f;
#pragma unroll
            for (int j = 0; j < 8; ++j) { e[j] = gelu_tanh(e[j]); s += e[j]; }
            const float mu = wave_sum(s) * (1.f / 512.f); float q = 0.f;
#pragma unroll
            for (int j = 0; j < 8; ++j) { e[j] -= mu; q += e[j] * e[j]; }
            const float rstd = rsqrtf(wave_sum(q) * (1.f / 512.f) + EPS);
            const f32x4 g0 = *(const f32x4*)(avg + lane * 8), g1 = *(const f32x4*)(avg + lane * 8 + 4);
            v4u o; o.x = pk2(e[0] * rstd * g0.x, e[1] * rstd * g0.y); o.y = pk2(e[2] * rstd * g0.z, e[3] * rstd * g0.w);
            o.z = pk2(e[4] * rstd * g1.x, e[5] * rstd * g1.y); o.w = pk2(e[6] * rstd * g1.z, e[7] * rstd * g1.w);
            *(v4u*)(VN + (size_t)row * 512 + lane * 8) = o;
        }
    }
}

#undef PREP_LOAD
__device__ __forceinline__ bf16x8 tr_frag(const LAS unsigned char* T, int stride, int i0, int i1, int c0, int fr, int fq) {
    const int off = (4 * fq + (fr >> 2)) * stride + (c0 + 4 * (fr & 3)) * 2;
    const s16x4 a = __builtin_amdgcn_ds_read_tr16_b64_v4i16((LAS s16x4*)(T + off + 16 * i0 * stride));
    const s16x4 b = __builtin_amdgcn_ds_read_tr16_b64_v4i16((LAS s16x4*)(T + off + 16 * i1 * stride));
    return (bf16x8){a[0], a[1], a[2], a[3], b[0], b[1], b[2], b[3]};
}
__device__ __forceinline__ bf16x8 rowp_frag(const LAS unsigned char* R, int stride, int i0, int i1, int r0, int fr, int fq) {
    const LAS unsigned char* p = R + (r0 + fr) * stride + 8 * fq;
    const s16x4 a = *(const LAS s16x4*)(p + 32 * i0), b = *(const LAS s16x4*)(p + 32 * i1);
    return (bf16x8){a[0], a[1], a[2], a[3], b[0], b[1], b[2], b[3]};
}
__device__ __forceinline__ v2u pack4(f32x4 v) { v2u o; o.x = pg8::cvt_pk_bf16(v[0], v[1]); o.y = pg8::cvt_pk_bf16(v[2], v[3]); return o; }
__device__ __forceinline__ v4u pack8(const float* e) { v4u o; o.x = pg8::cvt_pk_bf16(e[0], e[1]); o.y = pg8::cvt_pk_bf16(e[2], e[3]); o.z = pg8::cvt_pk_bf16(e[4], e[5]); o.w = pg8::cvt_pk_bf16(e[6], e[7]); return o; }
__device__ __forceinline__ void unpack8(v4u w, float* e) { e[0] = blo(w.x); e[1] = bhi(w.x); e[2] = blo(w.y); e[3] = bhi(w.y); e[4] = blo(w.z); e[5] = bhi(w.z); e[6] = blo(w.w); e[7] = bhi(w.w); }

__device__ __forceinline__ int gla_row0(int b, int c) { return c < 64 ? b * SEQ + 64 * c : ML + b * CTXL + 64 * (c - 64); }
constexpr int GL_LR = 0, GL_W2 = 8192, GL_BS = 16384, GL_BCF = 16896, GL_BCB = GL_BCF + 64 * 65 * 4, GL_OPS = GL_BCB + 64 * 65 * 4;
__device__ __forceinline__ void gla_gates(const Args& args, LAS unsigned char* lds, int l, int h, int row0, int tid) {
    const float* LR = (const float*)(args.ws + WS_LR);
    const float* w2 = args.in[14] + (size_t)l * 2 * 16 * 256, * db = args.in[15] + (size_t)l * 2 * 256;
    LAS float* lrS = (LAS float*)(lds + GL_LR); LAS float* w2S = (LAS float*)(lds + GL_W2); LAS float* bS = (LAS float*)(lds + GL_BS);
    LAS float* BCF = (LAS float*)(lds + GL_BCF); LAS float* BCB = (LAS float*)(lds + GL_BCB);
    *(LAS f32x4*)(lrS + tid * 4) = *(const f32x4*)(LR + (size_t)row0 * 32 + tid * 4);
    { const int j = tid * 4, dr = j >> 6, dk = j & 63; *(LAS f32x4*)(w2S + j) = *(const f32x4*)(w2 + dr * 256 + h * 64 + dk); }
    if (tid < 128) bS[tid] = db[(tid >> 6) * 256 + h * 64 + (tid & 63)];
    __syncthreads();
    { const int t = tid >> 3, dk0 = (tid & 7) * 8;
      float af[8], ab[8];
#pragma unroll
      for (int j = 0; j < 8; ++j) { af[j] = bS[dk0 + j]; ab[j] = bS[64 + dk0 + j]; }
#pragma unroll 4
      for (int r = 0; r < 16; ++r) { const float l0 = lrS[t * 32 + r], l1 = lrS[t * 32 + 16 + r];
#pragma unroll
          for (int j = 0; j < 8; ++j) { af[j] += l0 * w2S[r * 64 + dk0 + j]; ab[j] += l1 * w2S[(16 + r) * 64 + dk0 + j]; } }
#pragma unroll
      for (int j = 0; j < 8; ++j) { BCF[t * 65 + dk0 + j] = log_sigmoid(af[j]) * (1.f / 16.f); BCB[t * 65 + dk0 + j] = log_sigmoid(ab[j]) * (1.f / 16.f); } }
    __syncthreads();
    {
        const int dk = tid & 63, dir = (tid >> 6) & 1, seg = tid >> 7;
        LAS float* B = dir ? BCB : BCF; LAS float* tot = lrS;
        float v[16];
#pragma unroll
        for (int i = 0; i < 16; ++i) v[i] = B[(16 * seg + i) * 65 + dk];
        if (dir == 0) {
#pragma unroll
            for (int i = 1; i < 16; ++i) v[i] += v[i - 1];
        } else {
#pragma unroll
            for (int i = 14; i >= 0; --i) v[i] += v[i + 1];
        }
        tot[(dir * 4 + seg) * 64 + dk] = dir ? v[0] : v[15];
        __syncthreads();
        float off = 0.f;
#pragma unroll
        for (int s2 = 0; s2 < 4; ++s2) { const float tv = tot[(dir * 4 + s2) * 64 + dk]; off += (dir ? (s2 > seg) : (s2 < seg)) ? tv : 0.f; }
#pragma unroll
        for (int i = 0; i < 16; ++i) B[(16 * seg + i) * 65 + dk] = v[i] + off;
    }
    __syncthreads();
}
constexpr int G1_KOF = GL_OPS, G1_KOB = G1_KOF + 64 * 144, G1_V = G1_KOB + 64 * 144, G1_END = G1_V + 64 * 272;
__device__ __forceinline__ void gla1_unit(const Args& args, Frame& F, int l, int u) {
    PH_IDS;
    LAS unsigned char* lds = F.lds;
    const int h = u & 3, bc = u >> 2, b = bc / 68, c = bc % 68, row0 = gla_row0(b, c);
    const bf16* Z = (const bf16*)(args.ws + WS_Z);
    const int t = tid >> 3, dk0 = (tid & 7) * 8, c16 = (tid & 7) * 16;
    const bf16* zr = Z + (size_t)(row0 + t) * INC;
    const v4u kraw = *(const v4u*)(zr + COL_BK + h * 64 + dk0), vraw0 = *(const v4u*)(zr + COL_BV + h * 128 + c16), vraw1 = *(const v4u*)(zr + COL_BV + h * 128 + c16 + 8);
    gla_gates(args, lds, l, h, row0, tid);
    const LAS float* BCF = (const LAS float*)(lds + GL_BCF); const LAS float* BCB = (const LAS float*)(lds + GL_BCB);
    { float k[8], of[8], ob[8]; unpack8(kraw, k);
#pragma unroll
      for (int j = 0; j < 8; ++j) { of[j] = k[j] * __expf(BCF[63 * 65 + dk0 + j] - BCF[t * 65 + dk0 + j]); ob[j] = k[j] * __expf(BCB[dk0 + j] - BCB[t * 65 + dk0 + j]); }
      *(LAS v4u*)(lds + G1_KOF + t * 144 + dk0 * 2) = pack8(of); *(LAS v4u*)(lds + G1_KOB + t * 144 + dk0 * 2) = pack8(ob);
      *(LAS v4u*)(lds + G1_V + t * 272 + c16 * 2) = vraw0;
      *(LAS v4u*)(lds + G1_V + t * 272 + c16 * 2 + 16) = vraw1; }
    if (tid < 128) { const int dir = tid >> 6, dk = tid & 63;
        ((float*)(args.ws + WS_DEC))[((size_t)((b * 4 + h) * 2 + dir) * 68 + c) * 64 + dk] = __expf(dir ? BCB[dk] : BCF[63 * 65 + dk]); }
    __syncthreads();
    { const int fr = lane & 15, fq = lane >> 4, dir = wave >> 2, kt = wave & 3;
      const LAS unsigned char* KO = lds + (dir ? G1_KOB : G1_KOF);
      f32x4 acc[8];
#pragma unroll
      for (int nt = 0; nt < 8; ++nt) acc[nt] = (f32x4){0.f, 0.f, 0.f, 0.f};
#pragma unroll
      for (int ks = 0; ks < 2; ++ks) { const bf16x8 y = tr_frag(KO, 144, 2 * ks, 2 * ks + 1, 16 * kt, fr, fq);
#pragma unroll
          for (int nt = 0; nt < 8; ++nt) { const bf16x8 x = tr_frag(lds + G1_V, 272, 2 * ks, 2 * ks + 1, 16 * nt, fr, fq); acc[nt] = MFMA16(x, y, acc[nt]); } }
      float* st = (float*)(args.ws + WS_ST) + ((size_t)((b * 4 + h) * 2 + dir) * 68 + c) * 8192 + (size_t)(16 * kt + fr) * 128 + 4 * fq;
#pragma unroll
      for (int nt = 0; nt < 8; ++nt) *(f32x4*)(st + 16 * nt) = acc[nt]; }
    __syncthreads();
}
__device__ __forceinline__ void gla_scan(const Args& args, Frame& F) {
    PH_IDS;
    float* ST = (float*)(args.ws + WS_ST); const float* DEC = (const float*)(args.ws + WS_DEC);
    for (int e = blockIdx.x * 512 + tid; e < 32 * 4096; e += F.G * 512) {
        const int chain = e >> 12, idx = (e & 4095) * 2, dk = idx >> 7, dir = chain & 1;
        float* base = ST + (size_t)chain * 68 * 8192 + idx; const float* dbase = DEC + (size_t)chain * 68 * 64 + dk;
        float sx = 0.f, sy = 0.f;
        for (int s0 = 0; s0 < 68; s0 += 8) {
            float kx[8], ky[8], d[8]; int cc[8];
#pragma unroll
            for (int i = 0; i < 8; ++i) { const int s = s0 + i; cc[i] = s < 4 ? (dir ? 67 - s : 64 + s) : (dir ? 67 - s : s - 4);
                if (s < 68) { const float2 v = *(const float2*)(base + (size_t)cc[i] * 8192); kx[i] = v.x; ky[i] = v.y; d[i] = dbase[cc[i] * 64]; } else { kx[i] = 0.f; ky[i] = 0.f; d[i] = 1.f; } }
#pragma unroll
            for (int i = 0; i < 8; ++i) if (s0 + i < 68) { *(float2*)(base + (size_t)cc[i] * 8192) = make_float2(sx, sy); sx = sx * d[i] + kx[i]; sy = sy * d[i] + ky[i]; }
        }
    }
}
constexpr int G3_QF = GL_OPS, G3_QB = G3_QF + 64 * 144, G3_KF = G3_QB + 64 * 144, G3_KB = G3_KF + 64 * 144, G3_V = G3_KB + 64 * 144, G3_SF = G3_V + 64 * 272, G3_SB = G3_SF + 64 * 272,
              G3_END = G3_SB + 64 * 272, G3_P = 0  , G3_XS = 9216;
static_assert(G3_END <= LDSCTL_OFF && G3_XS + 512 <= GL_BCF, "GLA-3 LDS map");
__device__ __forceinline__ void gla3_unit(const Args& args, Frame& F, int l, int u) {
    PH_IDS;
    LAS unsigned char* lds = F.lds;
    const int h = u & 3, bc = u >> 2, b = bc / 68, c = bc % 68, row0 = gla_row0(b, c);
    const bf16* Z = (const bf16*)(args.ws + WS_Z); bf16* ABC = (bf16*)(args.ws + WS_ABC);
    const int t = tid >> 3, dk0 = (tid & 7) * 8, c16 = (tid & 7) * 16;
    const bf16* zr = Z + (size_t)(row0 + t) * INC;
    const v4u kraw = *(const v4u*)(zr + COL_BK + h * 64 + dk0), qraw = *(const v4u*)(zr + COL_BQ + h * 64 + dk0), vraw0 = *(const v4u*)(zr + COL_BV + h * 128 + c16), vraw1 = *(const v4u*)(zr + COL_BV + h * 128 + c16 + 8);
    f32x4 sraw[2][4];
#pragma unroll
    for (int dir = 0; dir < 2; ++dir) { const float* sp = (const float*)(args.ws + WS_ST) + ((size_t)((b * 4 + h) * 2 + dir) * 68 + c) * 8192 + (size_t)t * 128 + c16;
#pragma unroll
        for (int i = 0; i < 4; ++i) sraw[dir][i] = *(const f32x4*)(sp + 4 * i); }
    gla_gates(args, lds, l, h, row0, tid);
    const LAS float* BCF = (const LAS float*)(lds + GL_BCF); const LAS float* BCB = (const LAS float*)(lds + GL_BCB);
    { float k[8], q[8], a[8]; unpack8(kraw, k); unpack8(qraw, q);
      float ef[8], eb[8];
#pragma unroll
      for (int j = 0; j < 8; ++j) { ef[j] = __expf(BCF[t * 65 + dk0 + j]); eb[j] = __expf(BCB[t * 65 + dk0 + j]); }
#pragma unroll
      for (int j = 0; j < 8; ++j) a[j] = q[j] * 0.125f * ef[j];
      *(LAS v4u*)(lds + G3_QF + t * 144 + dk0 * 2) = pack8(a);
#pragma unroll
      for (int j = 0; j < 8; ++j) a[j] = q[j] * 0.125f * eb[j];
      *(LAS v4u*)(lds + G3_QB + t * 144 + dk0 * 2) = pack8(a);
#pragma unroll
      for (int j = 0; j < 8; ++j) a[j] = k[j] * __builtin_amdgcn_rcpf(ef[j]);
      *(LAS v4u*)(lds + G3_KF + t * 144 + dk0 * 2) = pack8(a);
#pragma unroll
      for (int j = 0; j < 8; ++j) a[j] = k[j] * __builtin_amdgcn_rcpf(eb[j]);
      *(LAS v4u*)(lds + G3_KB + t * 144 + dk0 * 2) = pack8(a);
      *(LAS v4u*)(lds + G3_V + t * 272 + c16 * 2) = vraw0;
      *(LAS v4u*)(lds + G3_V + t * 272 + c16 * 2 + 16) = vraw1;
#pragma unroll
      for (int dir = 0; dir < 2; ++dir) { const f32x4 s0 = sraw[dir][0], s1 = sraw[dir][1], s2 = sraw[dir][2], s3 = sraw[dir][3];
          v4u w0, w1; w0.x = pg8::cvt_pk_bf16(s0[0], s0[1]); w0.y = pg8::cvt_pk_bf16(s0[2], s0[3]); w0.z = pg8::cvt_pk_bf16(s1[0], s1[1]); w0.w = pg8::cvt_pk_bf16(s1[2], s1[3]);
          w1.x = pg8::cvt_pk_bf16(s2[0], s2[1]); w1.y = pg8::cvt_pk_bf16(s2[2], s2[3]); w1.z = pg8::cvt_pk_bf16(s3[0], s3[1]); w1.w = pg8::cvt_pk_bf16(s3[2], s3[3]);
          LAS unsigned char* dst = lds + (dir ? G3_SB : G3_SF) + t * 272 + c16 * 2; *(LAS v4u*)dst = w0; *(LAS v4u*)(dst + 16) = w1; } }
    __syncthreads();
    const int fr = lane & 15, fq = lane >> 4, tt = wave & 3, wh = wave >> 2;
    {
        f32x4 af[2], ab[2];
#pragma unroll
        for (int i = 0; i < 2; ++i) { af[i] = (f32x4){0.f, 0.f, 0.f, 0.f}; ab[i] = af[i]; }
#pragma unroll
        for (int ks = 0; ks < 2; ++ks) {
            const bf16x8 qf = *(const LAS bf16x8*)(lds + G3_QF + (16 * tt + fr) * 144 + (32 * ks + 8 * fq) * 2), qb = *(const LAS bf16x8*)(lds + G3_QB + (16 * tt + fr) * 144 + (32 * ks + 8 * fq) * 2);
#pragma unroll
            for (int i = 0; i < 2; ++i) { const int st = 2 * wh + i;
                const bf16x8 kf = *(const LAS bf16x8*)(lds + G3_KF + (16 * st + fr) * 144 + (32 * ks + 8 * fq) * 2), kb = *(const LAS bf16x8*)(lds + G3_KB + (16 * st + fr) * 144 + (32 * ks + 8 * fq) * 2);
                af[i] = MFMA16(kf, qf, af[i]); ab[i] = MFMA16(kb, qb, ab[i]); } }
        const int tq = 16 * tt + fr;
#pragma unroll
        for (int i = 0; i < 2; ++i) { const int s0 = 16 * (2 * wh + i) + 4 * fq; f32x4 p;
#pragma unroll
            for (int j = 0; j < 4; ++j) p[j] = (s0 + j <= tq ? af[i][j] : 0.f) + (s0 + j >= tq ? ab[i][j] : 0.f);
            *(LAS v2u*)(lds + G3_P + tq * 144 + s0 * 2) = pack4(p); }
    }
    __syncthreads();
    {
        f32x4 acc[4];
#pragma unroll
        for (int n = 0; n < 4; ++n) acc[n] = (f32x4){0.f, 0.f, 0.f, 0.f};
#pragma unroll
        for (int seg = 0; seg < 3; ++seg) { const LAS unsigned char* Y = lds + (seg == 0 ? G3_P : seg == 1 ? G3_QF : G3_QB); const LAS unsigned char* X = lds + (seg == 0 ? G3_V : seg == 1 ? G3_SF : G3_SB);
#pragma unroll
            for (int ks = 0; ks < 2; ++ks) { const bf16x8 y = rowp_frag(Y, 144, 2 * ks, 2 * ks + 1, 16 * tt, fr, fq);
#pragma unroll
                for (int n = 0; n < 4; ++n) { const bf16x8 x = tr_frag(X, 272, 2 * ks, 2 * ks + 1, 16 * (4 * wh + n), fr, fq); acc[n] = MFMA16(x, y, acc[n]); } } }
        float ss = 0.f;
#pragma unroll
        for (int n = 0; n < 4; ++n) ss += (acc[n][0] * acc[n][0] + acc[n][1] * acc[n][1]) + (acc[n][2] * acc[n][2] + acc[n][3] * acc[n][3]);
        ss += __shfl_xor(ss, 16); ss += __shfl_xor(ss, 32);
        LAS float* XS = (LAS float*)(lds + G3_XS);
        if (fq == 0) XS[(16 * tt + fr) * 2 + wh] = ss;
        __syncthreads();
        const int to = 16 * tt + fr;
        const float rstd = rsqrtf((XS[to * 2] + XS[to * 2 + 1]) * (1.f / 128.f) + EPS);
        const float* gn = args.in[16] + l * 128;
        const bf16* og = Z + (size_t)(row0 + to) * INC + COL_BG + h * 128; bf16* orow = ABC + (size_t)(row0 + to) * D + 512 + h * 128;
#pragma unroll
        for (int n = 0; n < 4; ++n) { const int dv = 16 * (4 * wh + n) + 4 * fq; const f32x4 g = *(const f32x4*)(gn + dv); const v2u ow = *(const v2u*)(og + dv);
            f32x4 y; y[0] = acc[n][0] * rstd * g[0] * silu_f(blo(ow.x)); y[1] = acc[n][1] * rstd * g[1] * silu_f(bhi(ow.x)); y[2] = acc[n][2] * rstd * g[2] * silu_f(blo(ow.y)); y[3] = acc[n][3] * rstd * g[3] * silu_f(bhi(ow.y));
            *(v2u*)(orow + dv) = pack4(y); }
    }
    __syncthreads();
}

constexpr int GM_WS = 0, GM_VN = 128 * 272;
__device__ __forceinline__ void gmlp_unit(const Args& args, Frame& F, int l, int u) {
    PH_IDS;
    LAS unsigned char* lds = F.lds;
    const int g = u & 3, r0 = (u >> 2) * 128;
    const bf16* Z = (const bf16*)(args.ws + WS_Z); const bf16* VN = (const bf16*)(args.ws + WS_VN); bf16* ABC = (bf16*)(args.ws + WS_ABC);
    const float* ws = args.in[11] + ((size_t)l * 4 + g) * 128 * 128, * bs = args.in[12] + ((size_t)l * 4 + g) * 128;
    { const int p = tid >> 2, q0 = (tid & 3) * 32;
#pragma unroll
      for (int i = 0; i < 4; ++i) { const f32x4 a = *(const f32x4*)(ws + p * 128 + q0 + 8 * i), b2 = *(const f32x4*)(ws + p * 128 + q0 + 8 * i + 4);
          v4u w; w.x = pg8::cvt_pk_bf16(a[0], a[1]); w.y = pg8::cvt_pk_bf16(a[2], a[3]); w.z = pg8::cvt_pk_bf16(b2[0], b2[1]); w.w = pg8::cvt_pk_bf16(b2[2], b2[3]);
          *(LAS v4u*)(lds + GM_WS + p * 272 + (q0 + 8 * i) * 2) = w;
          *(LAS v4u*)(lds + GM_VN + p * 272 + (q0 + 8 * i) * 2) = *(const v4u*)(VN + (size_t)(r0 + p) * 512 + g * 128 + q0 + 8 * i); } }
    __syncthreads();
    { const int fr = lane & 15, fq = lane >> 4, p0 = 16 * wave;
      f32x4 acc[8];
#pragma unroll
      for (int nt = 0; nt < 8; ++nt) acc[nt] = (f32x4){0.f, 0.f, 0.f, 0.f};
#pragma unroll
      for (int ks = 0; ks < 4; ++ks) { const bf16x8 y = rowp_frag(lds + GM_WS, 272, 2 * ks, 2 * ks + 1, p0, fr, fq);
#pragma unroll
          for (int nt = 0; nt < 8; ++nt) { const bf16x8 x = tr_frag(lds + GM_VN, 272, 2 * ks, 2 * ks + 1, 16 * nt, fr, fq); acc[nt] = MFMA16(x, y, acc[nt]); } }
      const int p = p0 + fr; const float bias = bs[p];
      const bf16* ur = Z + (size_t)(r0 + p) * INC + COL_AU + g * 128; bf16* orow = ABC + (size_t)(r0 + p) * D + g * 128;
#pragma unroll
      for (int nt = 0; nt < 8; ++nt) { const int d = 16 * nt + 4 * fq; const v2u uw = *(const v2u*)(ur + d);
          f32x4 y; y[0] = gelu_tanh(blo(uw.x)) * (acc[nt][0] + bias); y[1] = gelu_tanh(bhi(uw.x)) * (acc[nt][1] + bias); y[2] = gelu_tanh(blo(uw.y)) * (acc[nt][2] + bias); y[3] = gelu_tanh(bhi(uw.y)) * (acc[nt][3] + bias);
          *(v2u*)(orow + d) = pack4(y); } }
    __syncthreads();
}

constexpr int AT_K0 = 0, AT_V0 = 2 * 64 * 272, AT_TILE = 64 * 272;
__device__ __forceinline__ void attn_unit(const Args& args, Frame& F, int l, int u) {
    PH_IDS;
    LAS unsigned char* lds = F.lds;
    const bf16* Z = (const bf16*)(args.ws + WS_Z); const bf16* QN = (const bf16*)(args.ws + WS_QN); const bf16* KN = (const bf16*)(args.ws + WS_KN); bf16* ABC = (bf16*)(args.ws + WS_ABC);
    int b, kvh, qb, qrow0, jlo, nloc;
    if (u < 512) { b = u >> 7; kvh = (u >> 6) & 1; qb = u & 63; qrow0 = b * SEQ + 64 * qb; jlo = qb - 2 < 0 ? 0 : qb - 2; const int jhi = qb + 2 > 63 ? 63 : qb + 2; nloc = jhi - jlo + 1; }
    else { const int cu = u - 512; b = cu >> 3; kvh = (cu >> 2) & 1; qb = cu & 3; qrow0 = ML + b * CTXL + 64 * qb; jlo = 0; nloc = 0; }
    const int ntl = nloc + 4;
    const int fr = lane & 15, fq = lane >> 4, h = kvh * 4 + (wave >> 1), qoff = (wave & 1) * 32;
    bf16x8 bq[2][4];
#pragma unroll
    for (int qt = 0; qt < 2; ++qt)
#pragma unroll
        for (int ks = 0; ks < 4; ++ks) bq[qt][ks] = *(const bf16x8*)(QN + (size_t)(qrow0 + qoff + 16 * qt + fr) * 1024 + h * 128 + 32 * ks + 8 * fq);
    const float sink = args.in[19][l * 8 + h] * 1.4426950408889634f;
    float mrun[2] = {sink, sink}, lsum[2] = {1.f, 1.f};
    f32x4 o[8][2];
#pragma unroll
    for (int nt = 0; nt < 8; ++nt) { o[nt][0] = (f32x4){0.f, 0.f, 0.f, 0.f}; o[nt][1] = o[nt][0]; }
    v4u rk[2], rv[2];
    const int srow = tid >> 4, sch = (tid & 15) * 8;
#define AT_LOAD(i) do { const int _r0 = (i) < nloc ? b * SEQ + 64 * (jlo + (i)) : ML + b * CTXL + 64 * ((i) - nloc); \
        _Pragma("unroll") for (int _j = 0; _j < 2; ++_j) { const size_t _r = (size_t)(_r0 + srow + 32 * _j); rk[_j] = *(const v4u*)(KN + _r * 256 + kvh * 128 + sch); rv[_j] = *(const v4u*)(Z + _r * INC + COL_CV + kvh * 128 + sch); } } while (0)
#define AT_STORE(buf) do { _Pragma("unroll") for (int _j = 0; _j < 2; ++_j) { *(LAS v4u*)(lds + AT_K0 + (buf) * AT_TILE + (srow + 32 * _j) * 272 + sch * 2) = rk[_j]; *(LAS v4u*)(lds + AT_V0 + (buf) * AT_TILE + (srow + 32 * _j) * 272 + sch * 2) = rv[_j]; } } while (0)
    AT_LOAD(0); AT_STORE(0);
    __syncthreads();
    for (int i = 0; i < ntl; ++i) {
        if (i + 1 < ntl) AT_LOAD(i + 1);
        const LAS unsigned char* Kb = lds + AT_K0 + (i & 1) * AT_TILE; const LAS unsigned char* Vb = lds + AT_V0 + (i & 1) * AT_TILE;
        f32x4 s[4][2];
#pragma unroll
        for (int kt = 0; kt < 4; ++kt) { s[kt][0] = (f32x4){0.f, 0.f, 0.f, 0.f}; s[kt][1] = s[kt][0]; }
#pragma unroll
        for (int ks = 0; ks < 4; ++ks)
#pragma unroll
            for (int kt = 0; kt < 4; ++kt) { const bf16x8 a = *(const LAS bf16x8*)(Kb + (16 * kt + fr) * 272 + (32 * ks + 8 * fq) * 2);
                s[kt][0] = MFMA16(a, bq[0][ks], s[kt][0]); s[kt][1] = MFMA16(a, bq[1][ks], s[kt][1]); }
        if (i < nloc) { const int jt = jlo + i;
            if (jt == qb - 2 || jt == qb + 2) {
#pragma unroll
                for (int qt = 0; qt < 2; ++qt) { const int qpos = 64 * qb + qoff + 16 * qt + fr;
#pragma unroll
                    for (int kt = 0; kt < 4; ++kt)
#pragma unroll
                        for (int j = 0; j < 4; ++j) { const int dlt = qpos - (64 * jt + 16 * kt + 4 * fq + j); if (dlt > 128 || dlt < -128) s[kt][qt][j] = -__builtin_inff(); } } } }
        bf16x8 pf[2][2];
#pragma unroll
        for (int qt = 0; qt < 2; ++qt) {
            float mx = s[0][qt][0];
#pragma unroll
            for (int kt = 0; kt < 4; ++kt)
#pragma unroll
                for (int j = 0; j < 4; ++j) mx = fmaxf(mx, s[kt][qt][j]);
            mx = fmaxf(mx, __shfl_xor(mx, 16)); mx = fmaxf(mx, __shfl_xor(mx, 32));
            if (__any(mx - mrun[qt] > 8.f)) {
                const float mn = fmaxf(mrun[qt], mx), alpha = __builtin_amdgcn_exp2f(mrun[qt] - mn); mrun[qt] = mn; lsum[qt] *= alpha;
#pragma unroll
                for (int nt = 0; nt < 8; ++nt) o[nt][qt] *= alpha; }
            const float mref = mrun[qt]; float rs = 0.f;
#pragma unroll
            for (int kt = 0; kt < 4; ++kt)
#pragma unroll
                for (int j = 0; j < 4; ++j) { const float p = __builtin_amdgcn_exp2f(s[kt][qt][j] - mref); s[kt][qt][j] = p; rs += p; }
            rs += __shfl_xor(rs, 16); rs += __shfl_xor(rs, 32);
            lsum[qt] += rs;
#pragma unroll
            for (int kp = 0; kp < 2; ++kp) { const v2u lo = pack4(s[2 * kp][qt]), hi = pack4(s[2 * kp + 1][qt]); const v4u w = {lo.x, lo.y, hi.x, hi.y}; pf[qt][kp] = __builtin_bit_cast(bf16x8, w); }
        }
#pragma unroll
        for (int kp = 0; kp < 2; ++kp)
#pragma unroll
            for (int nt = 0; nt < 8; ++nt) { const bf16x8 x = tr_frag(Vb, 272, 2 * kp, 2 * kp + 1, 16 * nt, fr, fq);
                o[nt][0] = MFMA16(x, pf[0][kp], o[nt][0]); o[nt][1] = MFMA16(x, pf[1][kp], o[nt][1]); }
        if (i + 1 < ntl) AT_STORE((i + 1) & 1);
        __syncthreads();
    }
#undef AT_LOAD
#undef AT_STORE
#pragma unroll
    for (int qt = 0; qt < 2; ++qt) { const float inv = 1.f / lsum[qt]; bf16* orow = ABC + (size_t)(qrow0 + qoff + 16 * qt + fr) * D + 1024 + h * 128 + 4 * fq;
#pragma unroll
        for (int nt = 0; nt < 8; ++nt) *(v2u*)(orow + 16 * nt) = pack4(o[nt][qt] * inv); }
}

constexpr int NPL = 13, NPH = 1 + 2 * NPL;
__global__ void __launch_bounds__(NWAVES * 64, 2) fwd_kernel(Args args) {
    extern __shared__ __attribute__((aligned(16))) unsigned char lds[];
    Frame F;
    F.lds = (LAS unsigned char*)lds;
    F.tid = threadIdx.x; F.lane = F.tid & 63; F.wave = __builtin_amdgcn_readfirstlane(F.tid >> 6);
    F.G = gridDim.x; F.gw = blockIdx.x * NWAVES + F.wave; F.ngw = F.G * NWAVES;
    F.ws = args.ws;
    volatile LAS unsigned* MISC = (volatile LAS unsigned*)(F.lds + MISC_OFF);
    for (int u = F.tid; u < (LDS_BYTES - LDSCTL_OFF) / 4; u += NWAVES * 64) ((LAS unsigned*)(F.lds + LDSCTL_OFF))[u] = 0u;
    __syncthreads();
    const int lo = args.ph_lo, hi = args.ph_hi;
    XcdBarrier bar; bar.bar = (unsigned*)(F.ws + WS_CTL) + CW_BAR; bar.x = 0; bar.st = nullptr;
    if (hi - lo > 1) bar = xcd_barrier_post((unsigned*)(F.ws + WS_CTL) + CW_BAR, MISC + 8);
#ifndef PHMASK
#define PHMASK 0xFFFF
#endif
#define EN(j) ((PHMASK >> (j)) & 1)
#ifndef PROBE_DUP
#define PROBE_DUP 0x0
#endif
#define REPS(j) (1 + ((PROBE_DUP >> (j)) & 1))
#define IN(k) (lo <= (k) && (k) < hi)
#define SEAM(k) do { if (IN(k) && IN((k) + 1)) xcd_barrier(bar); } while (0)
    PG8_LAS unsigned char* ring = (PG8_LAS unsigned char*)(F.lds + RING_OFF);
    const int bx = blockIdx.x;

    if (EN(15) && IN(0)) for (int rep = 0; rep < REPS(15); ++rep) { phase_prologue(args, F); } SEAM(0);

    for (int l = 0; l < 2; ++l) {
        const int P = 1 + l * NPL;
        const bool lastl = (l == 1);
        bf16* HA = WSP(bf16, WS_HA); bf16* ACT = WSP(bf16, WS_Z); bf16* Zb = WSP(bf16, WS_Z); bf16* ABC = WSP(bf16, WS_ABC);
        float* xbuf = WSP(float, WS_XBUF);
        const float* PNONE = nullptr;
        bf16* HAc = HA + (size_t)ML * D; bf16* ACTc = ACT + (size_t)ML * FFN; bf16* ABCc = ABC + (size_t)ML * D;
        float* PART = WSP(float, WS_PART);
        if (EN(0) && IN(P + 0)) for (int rep = 0; rep < REPS(0); ++rep) { phase_norm<4>(args, F, l, 0, l == 0, MT, (l == 1 && rep == 0) ? modp(F, 0, 4, 8) : PNONE, 0.5f); } SEAM(P + 0);
        if (EN(1) && IN(P + 1)) for (int rep = 0; rep < REPS(1); ++rep) {
            { pg8::Gemm g{HA, wptr(F, l, WO_UP), D, D}; pg8::TwoPartOrder S; S.init(2 * FFN / 256, D, 2 * FFN / 256, 1, D, F.G, bx);
              pg8::EpiUp E{ACT, FFN, 0}; pg8::gemm_phase<pg8::EpiUp, pg8::TwoPartOrder>(ring, g, S, E); } } SEAM(P + 1);
        if (EN(2) && IN(P + 2)) for (int rep = 0; rep < REPS(2); ++rep) {
            { pg8::Gemm g{ACT, wptr(F, l, WO_DN), FFN, FFN}; pg8::TwoPartOrder S; S.init(D / 256, FFN, D / 256, 4, FFN / 4, F.G, bx);
              pg8::EpiResidPart E{{l == 0 ? args.in[0] : xbuf, xbuf, modp(F, l, 0, 2), NMOD * D, rep + 1 == REPS(2) ? 0.5f : 0.f}, {PART}}; pg8::gemm_phase<pg8::EpiResidPart, pg8::TwoPartOrder>(ring, g, S, E); } } SEAM(P + 2);
        if (EN(3) && IN(P + 3)) for (int rep = 0; rep < REPS(3); ++rep) { phase_norm<4>(args, F, l, 1, false, MT, rep == 0 ? modp(F, l, 4, 2) : PNONE, 0.5f); } SEAM(P + 3);
        if (EN(4) && IN(P + 4)) for (int rep = 0; rep < REPS(4); ++rep) {
            { pg8::Gemm g{HA, wptr(F, l, WO_IN), D, D}; pg8::TwoPartOrder S; S.init(INC / 256, D, (lastl ? 1280 : INC) / 256, 1, D, F.G, bx);
              pg8::EpiBf16 E{Zb, INC, 0, rep + 1 < REPS(4), COL_GATE / 256}; pg8::gemm_phase<pg8::EpiBf16, pg8::TwoPartOrder>(ring, g, S, E); }
            for (int rb = (bx + 192) % F.G; rb < MT / 64; rb += F.G) lr_block(args, F, l, rb);
        } SEAM(P + 4);
        if (EN(5) && IN(P + 5)) for (int rep = 0; rep < REPS(5); ++rep) { phase_prep(args, F, l); __syncthreads(); for (int u = bx; u < 4 * 4 * 68; u += F.G) gla1_unit(args, F, l, u); } SEAM(P + 5);
        if (EN(6) && IN(P + 6)) for (int rep = 0; rep < REPS(6); ++rep) { if (rep == 0) gla_scan(args, F);
            for (int u = bx; u < 512; u += F.G) attn_unit(args, F, l, u);
            __syncthreads();
            for (int u = (bx + 96) % F.G; u < 4 * ((lastl ? ML : MT) / 128); u += F.G) gmlp_unit(args, F, l, u); } SEAM(P + 6);
        if (EN(7) && IN(P + 7)) for (int rep = 0; rep < REPS(7); ++rep) { if (l == 0) { for (int u = 512 + bx; u < 544; u += F.G) attn_unit(args, F, l, u); __syncthreads(); }
            for (int u = (bx + 224) % F.G; u < 4 * 4 * (lastl ? 64 : 68); u += F.G) gla3_unit(args, F, l, lastl ? (u & 3) + 4 * ((u >> 2) % 64 + 68 * (u >> 8)) : u); } SEAM(P + 7);
        const int nMm = (lastl ? ML : MT) / 256;
        if (EN(8) && IN(P + 8)) for (int rep = 0; rep < REPS(8); ++rep) { pg8::Gemm g{ABC, wptr(F, l, WO_BRA), D, D}; pg8::MergeOrder S; S.init(nMm, D / 256, F.G, bx);
            pg8::EpiMergeR E{Zb + COL_GATE, INC, HA}; pg8::gemm_phase<pg8::EpiMergeR, pg8::MergeOrder>(ring, g, S, E); } SEAM(P + 8);
        if (EN(9) && IN(P + 9)) for (int rep = 0; rep < REPS(9); ++rep) {
            { pg8::Gemm g{HA, wptr(F, l, WO_OUT), D, D}; pg8::TwoPartOrder S; S.init(D / 256, D, lastl ? 0 : D / 256, 8, D / 8, F.G, bx);
              pg8::EpiResidPart E{{xbuf, xbuf, modp(F, l, 0, 5), NMOD * D, rep + 1 == REPS(9) ? 1.0f : 0.f}, {PART}}; pg8::gemm_phase<pg8::EpiResidPart, pg8::TwoPartOrder>(ring, g, S, E); } } SEAM(P + 9);
        if (EN(10) && IN(P + 10)) for (int rep = 0; rep < REPS(10); ++rep) { phase_norm<8>(args, F, l, 2, false, lastl ? ML : MT, (!lastl && rep == 0) ? modp(F, l, 4, 5) : PNONE, 1.0f); } SEAM(P + 10);
        if (EN(11) && IN(P + 11)) for (int rep = 0; rep < REPS(11); ++rep) {
            { pg8::Gemm g{HA, wptr(F, l, WO_UP + W_UP_E), D, D}; pg8::TwoPartOrder S; S.init(2 * FFN / 256, D, lastl ? 0 : 2 * FFN / 256, 1, D, F.G, bx);
              pg8::EpiUp E{ACT, FFN, 0}; pg8::gemm_phase<pg8::EpiUp, pg8::TwoPartOrder>(ring, g, S, E); } } SEAM(P + 11);
        if (EN(12) && IN(P + 12)) for (int rep = 0; rep < REPS(12); ++rep) {
            { pg8::Gemm g{ACT, wptr(F, l, WO_DN + W_DN_E), FFN, FFN}; pg8::TwoPartOrder S; S.init(D / 256, FFN, lastl ? 0 : D / 256, 4, FFN / 4, F.G, bx);
              pg8::EpiResidPart E{{xbuf, (lastl && rep + 1 == REPS(12)) ? args.out : xbuf, modp(F, l, 0, 8), NMOD * D, rep + 1 == REPS(12) ? 0.5f : 0.f}, {PART}}; pg8::gemm_phase<pg8::EpiResidPart, pg8::TwoPartOrder>(ring, g, S, E); } }
        if (!lastl) SEAM(P + 12);
    }
#undef IN
#undef SEAM
}

extern "C" void kernel_launch(void* const* d_in, const int* in_sizes, int n_in, void* d_out, int out_size, void* d_ws, size_t ws_size, hipStream_t stream) {
    static int grid = 0;
    if (grid == 0) {
        if (n_in != 24 || out_size != ML * D || ws_size < WS_END) { fprintf(stderr, "kernel_launch: unexpected shapes (n_in %d out %d ws %zu need %zu)\n", n_in, out_size, ws_size, (size_t)WS_END); grid = -1; return; }
        int dev = 0, cus = 0, per_cu = 0;
        if (hipGetDevice(&dev) != hipSuccess || hipDeviceGetAttribute(&cus, hipDeviceAttributeMultiprocessorCount, dev) != hipSuccess) { grid = -1; return; }
        if (hipFuncSetAttribute((const void*)fwd_kernel, hipFuncAttributeMaxDynamicSharedMemorySize, LDS_BYTES) != hipSuccess) { fprintf(stderr, "kernel_launch: hipFuncSetAttribute failed\n"); grid = -1; return; }
        if (hipOccupancyMaxActiveBlocksPerMultiprocessor(&per_cu, (const void*)fwd_kernel, NWAVES * 64, LDS_BYTES) != hipSuccess || per_cu < 1)
            fprintf(stderr, "kernel_launch: occupancy query reports %d blocks per CU\n", per_cu);
        (void)hipGetLastError();
        grid = cus;
    }
    if (grid < 0) return;
    if (hipMemsetAsync((char*)d_ws + WS_CTL, 0, CTL_ZERO_BYTES, stream) != hipSuccess) return;
    Args a{};
    for (int i = 0; i < 24; ++i) a.in[i] = (const float*)d_in[i];
    a.out = (float*)d_out; a.ws = (unsigned char*)d_ws;
#if N_LAUNCH_MODE == 1
    a.ph_lo = 0; a.ph_hi = NPH;
    hipLaunchKernelGGL(fwd_kernel, dim3(grid), dim3(NWAVES * 64), LDS_BYTES, stream, a);
#else
    for (int p = 0; p < NPH; ++p) { a.ph_lo = p; a.ph_hi = p + 1; hipLaunchKernelGGL(fwd_kernel, dim3(grid), dim3(NWAVES * 64), LDS_BYTES, stream, a); }
#endif
}
```

```cpp
#include <hip/hip_runtime.h>
#include <cstdio>
#include <cstdint>

#ifndef N_LAUNCH_MODE
#define N_LAUNCH_MODE 1
#endif

#ifndef PROBE_SKIPEPI
#define PROBE_SKIPEPI 0
#endif
namespace pg8 {
#define PG8_LAS __attribute__((address_space(3)))
typedef unsigned short bf16_t;
typedef short bf16x8 __attribute__((ext_vector_type(8)));
typedef float f32x4 __attribute__((ext_vector_type(4)));
typedef unsigned u32x4 __attribute__((ext_vector_type(4)));
typedef unsigned u32x2 __attribute__((ext_vector_type(2)));
constexpr int BM = 256, BK = 64, HALF = 128, HTB = HALF * BK * 2, STAGE_BYTES = 8 * HTB, NXCD = 8, WGM = 8;

__host__ __device__ __forceinline__ int lds_byte(int r, int c) { const int st = (r >> 4) * 2 + (c >> 5), rr = r & 15, cc = c & 31, ob = rr * 64 + cc * 2; return st * 1024 + (ob ^ (((ob >> 9) & 1) << 5)); }
__host__ __device__ __forceinline__ void stage_rc(int b, int& R, int& C) { const int st = b / 1024, sb = b % 1024, swz = sb ^ (((sb >> 9) & 1) << 5); R = (st >> 1) * 16 + swz / 64; C = (st & 1) * 32 + (swz % 64) / 2; }
__host__ __device__ __forceinline__ int perm32(int rho) { const int n = rho >> 4, i = rho & 15; return 8 * (i >> 2) + 4 * n + (i & 3); }

struct Unit { int pm, pn, ks, nt; unsigned koff; };
struct Gemm { const bf16_t* A; const bf16_t* Bt; int lda, ldb; };

struct StaticOrder {
    int nM, nN, nwg, G, c, nt;
    __host__ __device__ void init(int nM_, int nN_, int G_, int c_, int K_) { nM = nM_; nN = nN_; nwg = nM * nN; G = G_; c = c_; nt = K_ / BK; }
    __host__ __device__ bool next(int i, Unit& u) const {
        const long L = (long)i * G + c; if (L >= nwg) return false;
        int wgid = (int)L; { const int q = nwg / NXCD, r = nwg % NXCD, xcd = wgid % NXCD, off = wgid / NXCD; wgid = (xcd < r ? xcd * (q + 1) : r * (q + 1) + (xcd - r) * q) + off; }
        const int nig = WGM * nN, gid = wgid / nig, fm = gid * WGM, gsz = (nM - fm) < WGM ? (nM - fm) : WGM;
        u.pm = fm + ((wgid % nig) % gsz); u.pn = (wgid % nig) / gsz; u.ks = 0; u.koff = 0u; u.nt = nt; return true;
    }
    __device__ __forceinline__ void a_ready(const Unit&) const {}
    __device__ __forceinline__ void done(const Unit&) const {}
};
struct SplitOrder {
    int nM, nN, nS, G, c, K;
    __host__ __device__ void init(int nM_, int nN_, int nS_, int G_, int c_, int K_) { nM = nM_; nN = nN_; nS = nS_; G = G_; c = c_; K = K_; }
    __host__ __device__ bool next(int i, Unit& u) const {
        const long L = (long)i * G + c; if (L >= (long)nM * nN * nS) return false;
        const int x = (int)L; u.ks = x % nS; u.pn = (x / nS) % nN; u.pm = x / (nS * nN); u.koff = (unsigned)(u.ks * K * 2); u.nt = K / BK; return true;
    }
    __device__ __forceinline__ void a_ready(const Unit&) const {}
    __device__ __forceinline__ void done(const Unit&) const {}
};

struct TwoPartOrder {
    StaticOrder L; int nL, nNc, ns, Kc;
    __host__ __device__ void init(int nNl, int Kl, int nNc_, int ns_, int Kc_, int G_, int c_) { L.init(64, nNl, G_, c_, Kl); nL = 64 * nNl; nNc = nNc_; ns = ns_; Kc = Kc_; }
    __host__ __device__ bool next(int i, Unit& u) const {
        const long Lx = (long)i * L.G + L.c;
        if (Lx < nL) return L.next(i, u);
        const int x = (int)(Lx - nL); if (x >= 4 * nNc * ns) return false;
        u.ks = x % ns; u.pn = (x / ns) % nNc; u.pm = 64 + x / (ns * nNc); u.koff = (unsigned)(u.ks * Kc * 2); u.nt = Kc / BK; return true;
    }
    __device__ __forceinline__ void a_ready(const Unit&) const {}
    __device__ __forceinline__ void done(const Unit&) const {}
};
struct MergeOrder {
    StaticOrder T;
    __host__ __device__ void init(int nM_, int nN_, int G_, int c_) { T.init(nM_, nN_, G_, c_, 0); }
    __host__ __device__ bool next(int i, Unit& u) const {
        const int it = i / 3, seg = i - 3 * it;
        if (!T.next(it, u)) return false;
        u.ks = seg; u.koff = seg == 0 ? 0u : (seg == 1 ? 1024u : 2048u); u.nt = seg == 2 ? 16 : 8; return true;
    }
    __device__ __forceinline__ void a_ready(const Unit&) const {}
    __device__ __forceinline__ void done(const Unit&) const {}
};
__device__ __forceinline__ unsigned cvt_pk_bf16(float lo, float hi) { unsigned r; asm volatile("v_cvt_pk_bf16_f32 %0, %1, %2" : "=v"(r) : "v"(lo), "v"(hi)); return r; }
__device__ __forceinline__ float bf_lo(unsigned w) { return __uint_as_float(w << 16); }
__device__ __forceinline__ float bf_hi(unsigned w) { return __uint_as_float(w & 0xffff0000u); }
__device__ __forceinline__ float fast_sigmoid(float x) { return __builtin_amdgcn_rcpf(1.0f + __expf(-x)); }

struct EpiBf16 {
    static constexpr bool PERM = true;
    bf16_t* O; int ldc; int pm_off; int skip; int gate_pn;
    __device__ __forceinline__ void operator()(const f32x4 (&acc)[2][2][4][2], const Unit& u, int wr, int wc, int fr, int fq) const {
        if (PROBE_SKIPEPI && skip) return;
        const int row0 = (u.pm + pm_off) * BM + wr * 64 + fr, col0 = u.pn * BM + wc * 32 + 8 * fq;
        const bool gate = u.pn >= gate_pn;
#pragma unroll
        for (int ai = 0; ai < 2; ++ai)
#pragma unroll
            for (int m = 0; m < 4; ++m) { bf16_t* rowp = O + (size_t)(row0 + ai * HALF + m * 16) * ldc + col0;
#pragma unroll
                for (int bj = 0; bj < 2; ++bj) { f32x4 v0 = acc[ai][bj][m][0], v1 = acc[ai][bj][m][1];
                    if (gate) {
#pragma unroll
                        for (int j = 0; j < 4; ++j) { v0[j] = 1.0f + __expf(-fminf(fmaxf(v0[j], -30.f), 30.f)); v1[j] = 1.0f + __expf(-fminf(fmaxf(v1[j], -30.f), 30.f)); } }
                    u32x4 w; w.x = cvt_pk_bf16(v0[0], v0[1]); w.y = cvt_pk_bf16(v0[2], v0[3]); w.z = cvt_pk_bf16(v1[0], v1[1]); w.w = cvt_pk_bf16(v1[2], v1[3]);
                    *(u32x4*)(rowp + bj * HALF) = w; } }
    }
};
struct EpiUp {
    static constexpr bool PERM = true;
    bf16_t* O; int ldc; int pm_off;
    __device__ __forceinline__ void operator()(const f32x4 (&acc)[2][2][4][2], const Unit& u, int wr, int wc, int fr, int fq) const {
        const int row0 = (u.pm + pm_off) * BM + wr * 64 + fr, col0 = u.pn * HALF + wc * 32 + 8 * fq;
#pragma unroll
        for (int ai = 0; ai < 2; ++ai)
#pragma unroll
            for (int m = 0; m < 4; ++m) { bf16_t* rowp = O + (size_t)(row0 + ai * HALF + m * 16) * ldc + col0;
                f32x4 r0, r1;
#pragma unroll
                for (int j = 0; j < 4; ++j) { const float g0 = acc[ai][0][m][0][j], g1 = acc[ai][0][m][1][j];
                    r0[j] = g0 * fast_sigmoid(g0) * acc[ai][1][m][0][j]; r1[j] = g1 * fast_sigmoid(g1) * acc[ai][1][m][1][j]; }
                u32x4 w; w.x = cvt_pk_bf16(r0[0], r0[1]); w.y = cvt_pk_bf16(r0[2], r0[3]); w.z = cvt_pk_bf16(r1[0], r1[1]); w.w = cvt_pk_bf16(r1[2], r1[3]);
                *(u32x4*)rowp = w; }
    }
};
struct EpiResid {
    static constexpr bool PERM = false;
    const float* xin; float* xout; const float* gate; int gate_stride; float scale;
    __device__ __forceinline__ void operator()(const f32x4 (&acc)[2][2][4][2], const Unit& u, int wr, int wc, int fr, int fq) const {
        if (PROBE_SKIPEPI && scale == 0.f) return;
        const int row0 = u.pm * BM + wr * 64 + fr, col0 = u.pn * BM + wc * 32 + 4 * fq;
        const int bidx = u.pm >> 4;
        f32x4 gv[2][2];
#pragma unroll
        for (int bj = 0; bj < 2; ++bj)
#pragma unroll
            for (int n = 0; n < 2; ++n) gv[bj][n] = *(const f32x4*)(gate + (size_t)bidx * gate_stride + col0 + bj * HALF + n * 16) * scale;
#pragma unroll
        for (int ai = 0; ai < 2; ++ai)
#pragma unroll
            for (int mh = 0; mh < 2; ++mh) { f32x4 xv[2][2][2];
#pragma unroll
                for (int mm = 0; mm < 2; ++mm) { const size_t off = (size_t)(row0 + ai * HALF + (2 * mh + mm) * 16) * 2048 + col0;
#pragma unroll
                    for (int bj = 0; bj < 2; ++bj)
#pragma unroll
                        for (int n = 0; n < 2; ++n) xv[mm][bj][n] = *(const f32x4*)(xin + off + bj * HALF + n * 16); }
#pragma unroll
                for (int mm = 0; mm < 2; ++mm) { const size_t off = (size_t)(row0 + ai * HALF + (2 * mh + mm) * 16) * 2048 + col0;
#pragma unroll
                    for (int bj = 0; bj < 2; ++bj)
#pragma unroll
                        for (int n = 0; n < 2; ++n) *(f32x4*)(xout + off + bj * HALF + n * 16) = xv[mm][bj][n] + gv[bj][n] * acc[ai][bj][2 * mh + mm][n]; } }
    }
};
struct EpiPart {
    static constexpr bool PERM = false;
    float* P;
    __device__ __forceinline__ void operator()(const f32x4 (&acc)[2][2][4][2], const Unit& u, int wr, int wc, int fr, int fq) const {
        const int row0 = u.pm * BM + wr * 64 + fr, col0 = u.pn * BM + wc * 32 + 4 * fq;
        float* base = P + (size_t)u.ks * 1024 * 2048;
#pragma unroll
        for (int ai = 0; ai < 2; ++ai)
#pragma unroll
            for (int m = 0; m < 4; ++m) { float* rowp = base + (size_t)(row0 + ai * HALF + m * 16) * 2048 + col0;
#pragma unroll
                for (int bj = 0; bj < 2; ++bj)
#pragma unroll
                    for (int n = 0; n < 2; ++n) *(f32x4*)(rowp + bj * HALF + n * 16) = acc[ai][bj][m][n]; }
    }
};
struct EpiMergeR {
    static constexpr bool PERM = true;
    const bf16_t* zg; int ldz; bf16_t* O;
    __device__ __forceinline__ bool keep(const Unit& u) const { return u.ks < 2; }
    __device__ __forceinline__ void operator()(f32x4 (&acc)[2][2][4][2], const Unit& u, int wr, int wc, int fr, int fq) const {
        const int row0 = u.pm * BM + wr * 64 + fr, col0 = u.pn * BM + wc * 32 + 8 * fq, seg = u.ks;
        const int cnum = (seg == 0 ? 1 : 2) * 2048, cden = (seg == 0 ? 0 : (seg == 1 ? 1 : 2)) * 2048;
#pragma unroll
        for (int ai = 0; ai < 2; ++ai)
#pragma unroll
            for (int mh = 0; mh < 2; ++mh) { u32x4 zn[2][2], zd[2][2];
#pragma unroll
                for (int mm = 0; mm < 2; ++mm) { const size_t row = (size_t)(row0 + ai * HALF + (2 * mh + mm) * 16);
#pragma unroll
                    for (int bj = 0; bj < 2; ++bj) { zd[mm][bj] = *(const u32x4*)(zg + row * ldz + cden + col0 + bj * HALF);
                        zn[mm][bj] = seg < 2 ? *(const u32x4*)(zg + row * ldz + cnum + col0 + bj * HALF) : (u32x4){0u, 0u, 0u, 0u}; } }
#pragma unroll
                for (int mm = 0; mm < 2; ++mm) { const size_t row = (size_t)(row0 + ai * HALF + (2 * mh + mm) * 16); const int m = 2 * mh + mm;
#pragma unroll
                    for (int bj = 0; bj < 2; ++bj) { const u32x4 d4 = zd[mm][bj], n4 = zn[mm][bj];
                        const float dz[8] = {bf_lo(d4.x), bf_hi(d4.x), bf_lo(d4.y), bf_hi(d4.y), bf_lo(d4.z), bf_hi(d4.z), bf_lo(d4.w), bf_hi(d4.w)};
                        const float nz[8] = {bf_lo(n4.x), bf_hi(n4.x), bf_lo(n4.y), bf_hi(n4.y), bf_lo(n4.z), bf_hi(n4.z), bf_lo(n4.w), bf_hi(n4.w)};
                        float r[8];
#pragma unroll
                        for (int e = 0; e < 8; ++e) { const float num = seg < 2 ? nz[e] : 1.0f; r[e] = num * __builtin_amdgcn_rcpf(dz[e]); }
                        f32x4 v0 = acc[ai][bj][m][0], v1 = acc[ai][bj][m][1];
                        v0[0] *= r[0]; v0[1] *= r[1]; v0[2] *= r[2]; v0[3] *= r[3]; v1[0] *= r[4]; v1[1] *= r[5]; v1[2] *= r[6]; v1[3] *= r[7];
                        if (seg < 2) { acc[ai][bj][m][0] = v0; acc[ai][bj][m][1] = v1; }
                        else { u32x4 w; w.x = cvt_pk_bf16(v0[0], v0[1]); w.y = cvt_pk_bf16(v0[2], v0[3]); w.z = cvt_pk_bf16(v1[0], v1[1]); w.w = cvt_pk_bf16(v1[2], v1[3]);
                            *(u32x4*)(O + row * 2048 + col0 + bj * HALF) = w; } } } }
    }
};
struct EpiResidPart {
    static constexpr bool PERM = false;
    EpiResid R; EpiPart P;
    __device__ __forceinline__ void operator()(const f32x4 (&acc)[2][2][4][2], const Unit& u, int wr, int wc, int fr, int fq) const {
        if (u.pm < 64) R(acc, u, wr, wc, fr, fq); else { Unit v = u; v.pm = u.pm - 64; P(acc, v, wr, wc, fr, fq); }
    }
};
template <class E> __device__ __forceinline__ auto epi_keep(const E& e, const Unit& u, int) -> decltype(e.keep(u)) { return e.keep(u); }
template <class E> __device__ __forceinline__ bool epi_keep(const E&, const Unit&, long) { return false; }
template <class Epi, class Sched, bool ALIGN_EPI = true>
__device__ __forceinline__ void gemm_phase(PG8_LAS unsigned char* lds, const Gemm g, const Sched& S, const Epi& E) {
    int tid_ = threadIdx.x; asm volatile("" : "+v"(tid_));
    const int tid = tid_, wid = __builtin_amdgcn_readfirstlane(tid >> 6), lane = tid & 63, wr = wid >> 2, wc = wid & 3, fr = lane & 15, fq = lane >> 4;
    unsigned voffA[2], voffB[2];
#pragma unroll
    for (int i = 0; i < 2; ++i) { int R, C; stage_rc(tid * 16 + i * 8192, R, C); const int Rb = Epi::PERM ? ((R & ~31) + perm32(R & 31)) : R;
        voffA[i] = (unsigned)(R * g.lda + C) * 2u; voffB[i] = (unsigned)(Rb * g.ldb + C) * 2u; }
    const size_t kstep = (size_t)(BK * 2);
    const size_t hA = (size_t)HALF * g.lda * 2, hB = (size_t)HALF * g.ldb * 2;
    const size_t tA = 2 * hA, tB = 2 * hB;
    const unsigned ldsw = (unsigned)wid * 1024u;
    const int aoff = lds_byte(wr * 64 + fr, fq * 8), boff = lds_byte(wc * 32 + fr, fq * 8);
#define PG8_SA(b, h) (((b) * 2 + (h)) * HTB)
#define PG8_SB(b, h) ((4 + (b) * 2 + (h)) * HTB)
#define PG8_STAGE(bufoff, gbase, voff) do { _Pragma("unroll") for (int _i = 0; _i < 2; ++_i) \
        __builtin_amdgcn_global_load_lds((const unsigned*)((const char*)(gbase) + (voff)[_i]), (PG8_LAS unsigned*)(lds + (bufoff) + ldsw + _i * 8192), 16, 0, 0); } while (0)
#define PG8_LDA(dst, b, h) do { _Pragma("unroll") for (int m = 0; m < 4; ++m) _Pragma("unroll") for (int k = 0; k < 2; ++k) dst[m][k] = *(const PG8_LAS bf16x8*)(lds + PG8_SA(b, h) + aoff + m * 2048 + k * 1024); } while (0)
#define PG8_LDB(dst, b, h) do { _Pragma("unroll") for (int n = 0; n < 2; ++n) _Pragma("unroll") for (int k = 0; k < 2; ++k) dst[n][k] = *(const PG8_LAS bf16x8*)(lds + PG8_SB(b, h) + boff + n * 2048 + k * 1024); } while (0)
#define PG8_MMA(ai, bj, At, Bt) do { __builtin_amdgcn_s_setprio(1); _Pragma("unroll") for (int m = 0; m < 4; ++m) _Pragma("unroll") for (int n = 0; n < 2; ++n) _Pragma("unroll") for (int k = 0; k < 2; ++k) \
        acc[ai][bj][m][n] = __builtin_amdgcn_mfma_f32_16x16x32_bf16(Bt[n][k], At[m][k], acc[ai][bj][m][n], 0, 0, 0); __builtin_amdgcn_s_setprio(0); } while (0)
#define PG8_WAIT_V(n) asm volatile("s_waitcnt vmcnt(" #n ")" ::: "memory")
#define PG8_WAIT_L(n) asm volatile("s_waitcnt lgkmcnt(" #n ")" ::: "memory")
#define PG8_BAR __builtin_amdgcn_s_barrier()
#define PG8_SCHED __builtin_amdgcn_sched_barrier(0)
    Unit cur, nxt; int ui = 0;
    if (!S.next(0, cur)) return;
    f32x4 acc[2][2][4][2];
#pragma unroll
    for (int a = 0; a < 2; ++a)
#pragma unroll
        for (int b = 0; b < 2; ++b)
#pragma unroll
            for (int m = 0; m < 4; ++m)
#pragma unroll
                for (int n = 0; n < 2; ++n) acc[a][b][m][n] = (f32x4){0.f, 0.f, 0.f, 0.f};
    bf16x8 At[4][2], B0[2][2], B1[2][2];
    const char* cA = (const char*)g.A + (size_t)cur.pm * tA + cur.koff; const char* cB = (const char*)g.Bt + (size_t)cur.pn * tB + cur.koff;
    S.a_ready(cur);
    PG8_STAGE(PG8_SB(0, 0), cB, voffB); PG8_STAGE(PG8_SB(0, 1), cB + hB, voffB); PG8_STAGE(PG8_SA(0, 0), cA, voffA); PG8_STAGE(PG8_SA(0, 1), cA + hA, voffA);
    if (wr == 1) PG8_BAR;
    PG8_WAIT_V(2); PG8_BAR;
    PG8_STAGE(PG8_SB(1, 0), cB + kstep, voffB); PG8_STAGE(PG8_SA(1, 0), cA + kstep, voffA); PG8_STAGE(PG8_SB(1, 1), cB + hB + kstep, voffB);
    PG8_WAIT_V(6); PG8_BAR;
    for (;;) {
        const bool has_next = S.next(ui + 1, nxt);
        const char* nA = has_next ? (const char*)g.A + (size_t)nxt.pm * tA + nxt.koff : cA; const char* nB = has_next ? (const char*)g.Bt + (size_t)nxt.pn * tB + nxt.koff : cB;
        const int nt = cur.nt;
        for (int t = 0; t < nt; t += 2) {
            const bool last = (t == nt - 2);
            const char* a1 = cA + (size_t)(t + 1) * kstep;
            const char* a2 = last ? nA : cA + (size_t)(t + 2) * kstep; const char* b2 = last ? nB : cB + (size_t)(t + 2) * kstep;
            const char* a3 = a2 + kstep; const char* b3 = b2 + kstep;
            if (last && has_next) S.a_ready(nxt);
            PG8_LDB(B0, 0, 0); PG8_LDB(B1, 0, 1); PG8_SCHED; PG8_LDA(At, 0, 0); PG8_STAGE(PG8_SA(1, 1), a1 + hA, voffA);
            PG8_WAIT_V(8); PG8_WAIT_L(0); PG8_BAR; PG8_MMA(0, 0, At, B0); PG8_MMA(0, 1, At, B1); PG8_BAR; PG8_SCHED;
            PG8_LDA(At, 0, 1); PG8_STAGE(PG8_SB(0, 0), b2, voffB); PG8_STAGE(PG8_SB(0, 1), b2 + hB, voffB); PG8_STAGE(PG8_SA(0, 0), a2, voffA);
            PG8_WAIT_V(8); PG8_WAIT_L(0); PG8_BAR; PG8_MMA(1, 0, At, B0); PG8_MMA(1, 1, At, B1); PG8_BAR; PG8_SCHED;
            PG8_LDB(B0, 1, 0); PG8_LDB(B1, 1, 1); PG8_SCHED; PG8_LDA(At, 1, 0); PG8_STAGE(PG8_SA(0, 1), a2 + hA, voffA);
            PG8_WAIT_V(8); PG8_WAIT_L(0); PG8_BAR; PG8_MMA(0, 0, At, B0); PG8_MMA(0, 1, At, B1); PG8_BAR; PG8_SCHED;
            PG8_LDA(At, 1, 1); PG8_STAGE(PG8_SB(1, 0), b3, voffB); PG8_STAGE(PG8_SB(1, 1), b3 + hB, voffB); PG8_STAGE(PG8_SA(1, 0), a3, voffA);
            PG8_WAIT_V(8); PG8_WAIT_L(0); PG8_BAR; PG8_MMA(1, 0, At, B0); PG8_MMA(1, 1, At, B1); PG8_BAR; PG8_SCHED;
        }
        if constexpr (ALIGN_EPI) { if (wr == 0) PG8_BAR; }
        E(acc, cur, wr, wc, fr, fq); S.done(cur);
        if (!has_next) break;
        if (!epi_keep(E, cur, 0)) {
#pragma unroll
        for (int a = 0; a < 2; ++a)
#pragma unroll
            for (int b = 0; b < 2; ++b)
#pragma unroll
                for (int m = 0; m < 4; ++m)
#pragma unroll
                    for (int n = 0; n < 2; ++n) acc[a][b][m][n] = (f32x4){0.f, 0.f, 0.f, 0.f};
        }
        cur = nxt; cA = nA; cB = nB; ++ui;
        if constexpr (ALIGN_EPI) { if (wr == 1) PG8_BAR; }
    }
    PG8_WAIT_V(0);
    if constexpr (!ALIGN_EPI) { if (wr == 0) PG8_BAR; }
    PG8_BAR;
#undef PG8_SA
#undef PG8_SB
#undef PG8_STAGE
#undef PG8_LDA
#undef PG8_LDB
#undef PG8_MMA
#undef PG8_WAIT_V
#undef PG8_WAIT_L
#undef PG8_BAR
#undef PG8_SCHED
}
}

constexpr int NWAVES = 8;
constexpr int D = 2048, BATCH = 4, SEQ = 4096, CTXL = 256, FFN = 5632, INC = 10240, NMOD = 9;
constexpr int ML = BATCH * SEQ, MC = BATCH * CTXL, MT = ML + MC;
constexpr int COL_BK = 0, COL_BV = 256, COL_CK = 768, COL_CV = 1024, COL_AU = 1280, COL_AV = 1792, COL_BQ = 2304, COL_BG = 2560, COL_CQ = 3072, COL_GATE = 4096;
constexpr float EPS = 1e-6f;

constexpr size_t MiB = 1u << 20;
constexpr size_t al(size_t x) { return (x + 4095) & ~(size_t)4095; }
constexpr size_t WS_CTL = 0, CTL_ZERO_BYTES = 1 * MiB;
constexpr size_t WS_MOD = 1 * MiB;
constexpr size_t WS_W = 2 * MiB;
constexpr size_t W_UP_E = (size_t)2 * FFN * D, W_DN_E = (size_t)D * FFN, W_IN_E = (size_t)INC * D, W_BRA_E = (size_t)D * 512, W_BRC_E = (size_t)D * 1024, W_OUT_E = (size_t)D * D, W_LR_E = (size_t)256 * D;
constexpr size_t WO_UP = 0, WO_DN = WO_UP + 2 * W_UP_E, WO_IN = WO_DN + 2 * W_DN_E, WO_BRA = WO_IN + W_IN_E, WO_BRB = WO_BRA + W_BRA_E, WO_BRC = WO_BRB + W_BRA_E, WO_OUT = WO_BRC + W_BRC_E, WO_LR = WO_OUT + W_OUT_E,
                 W_LAYER_E = WO_LR + W_LR_E;
constexpr size_t WS_XBUF = al(WS_W + 2 * W_LAYER_E * 2);
constexpr size_t WS_HA = al(WS_XBUF + (size_t)MT * D * 4);
constexpr size_t WS_ABC = al(WS_HA + (size_t)MT * D * 2);
constexpr size_t WS_Z = al(WS_ABC + (size_t)MT * D * 2);
constexpr size_t WS_MIX = al(WS_Z + (size_t)MT * INC * 2);
constexpr size_t WS_QN = WS_MIX;
constexpr size_t WS_KN = al(WS_QN + (size_t)MT * 1024 * 2);
constexpr size_t WS_VN = al(WS_KN + (size_t)MT * 256 * 2);
constexpr size_t WS_LR = al(WS_VN + (size_t)MT * 512 * 2);
constexpr size_t WS_ST = al(WS_LR + (size_t)MT * 32 * 4);
constexpr size_t WS_DEC = al(WS_ST + (size_t)32 * 68 * 8192 * 4);
constexpr size_t WS_MIX_USED = al(WS_DEC + (size_t)32 * 68 * 64 * 4);
constexpr size_t WS_MIX_END = (WS_MIX_USED > WS_MIX + (size_t)MT * D * 4) ? WS_MIX_USED : al(WS_MIX + (size_t)MT * D * 4);
constexpr size_t WS_MERGEF = WS_MIX;
static_assert(WS_MERGEF + (size_t)MT * D * 4 <= WS_MIX_END, "MERGEF overlay");
constexpr size_t WS_PART = WS_MIX_END;
constexpr size_t WS_END = WS_PART + (size_t)8 * MC * D * 4;
static_assert(WS_END <= (size_t)1476395008, "workspace map exceeds the guaranteed d_ws size");
constexpr int CW_BAR = 4096;

constexpr int RING_OFF = 0, RING_BYTES = 131072;
constexpr int LDS_BYTES = 147456;
constexpr int LDSCTL_OFF = LDS_BYTES - 512, MISC_OFF = LDSCTL_OFF + 320;

#define GAS __attribute__((address_space(1)))
#define LAS __attribute__((address_space(3)))
typedef unsigned short bf16;
typedef unsigned v4u __attribute__((ext_vector_type(4)));
typedef unsigned v2u __attribute__((ext_vector_type(2)));
typedef float f32x4 __attribute__((ext_vector_type(4)));
typedef short bf16x8 __attribute__((ext_vector_type(8)));
typedef short s16x4 __attribute__((ext_vector_type(4)));
#define MFMA16(a, b, c) __builtin_amdgcn_mfma_f32_16x16x32_bf16((a), (b), (c), 0, 0, 0)
#define LDS_WAIT() asm volatile("s_waitcnt lgkmcnt(0)" ::: "memory")
#define VM_WAIT() asm volatile("s_waitcnt vmcnt(0)" ::: "memory")
__device__ __forceinline__ unsigned f2bf(float f) { unsigned u = __builtin_bit_cast(unsigned, f); return (u + 0x7fffu + ((u >> 16) & 1u)) >> 16; }
__device__ __forceinline__ unsigned pk2(float lo, float hi) { return f2bf(lo) | (f2bf(hi) << 16); }
__device__ __forceinline__ float bf2f(bf16 b) { return __uint_as_float(((unsigned)b) << 16); }
__device__ __forceinline__ float blo(unsigned w) { return __uint_as_float(w << 16); }
__device__ __forceinline__ float bhi(unsigned w) { return __uint_as_float(w & 0xffff0000u); }
__device__ __forceinline__ float wave_sum(float v) {
#pragma unroll
    for (int o = 1; o < 64; o <<= 1) v += __shfl_xor(v, o);
    return v;
}
__device__ __forceinline__ float wave_max(float v) {
#pragma unroll
    for (int o = 1; o < 64; o <<= 1) v = fmaxf(v, __shfl_xor(v, o));
    return v;
}
__device__ __forceinline__ float silu_f(float x) { return x / (1.0f + __expf(-x)); }
__device__ __forceinline__ float gelu_tanh(float x) { const float u = 1.5957691216057308f * (x + 0.044715f * x * x * x); return x * __builtin_amdgcn_rcpf(1.0f + __expf(-u)); }
__device__ __forceinline__ float log_sigmoid(float x) { return fminf(x, 0.f) - __logf(1.0f + __expf(-fabsf(x))); }

#define XB_TMO      128
#define XB_XCNT(j)  (256  + 64 * (j))
#define XB_XSUB(j)  (1280 + 64 * (j))
#define XB_XGEN(j)  (2304 + 64 * (j))
#define XB_TOP      3328
#define XB_TOPGEN   3392
#define XCD_BAR_WORDS 3456
#define XB_SPIN_CAP (1u << 18)
__device__ __forceinline__ unsigned xb_ld(unsigned* p)              { return __hip_atomic_load(p, __ATOMIC_RELAXED, __HIP_MEMORY_SCOPE_AGENT); }
__device__ __forceinline__ unsigned xb_add(unsigned* p, unsigned v) { return __hip_atomic_fetch_add(p, v, __ATOMIC_RELAXED, __HIP_MEMORY_SCOPE_AGENT); }
__device__ __forceinline__ unsigned xb_xcc_id() { return (unsigned)__builtin_amdgcn_s_getreg((3 << 11) | 20) & 0xFu; }
#define XB_SPIN(cond, bar) do { unsigned _sp = 0; while (cond) { __builtin_amdgcn_s_sleep(1); \
    if ((++_sp & 255u) == 0u) { if (xb_ld(&(bar)[XB_TMO])) break; if (_sp > XB_SPIN_CAP) { atomicAdd(&(bar)[XB_TMO], 1u); break; } } } } while (0)
struct XcdBarrier { unsigned* bar; unsigned x; volatile LAS unsigned* st; };
__device__ __forceinline__ XcdBarrier xcd_barrier_post(unsigned* bar, volatile LAS unsigned* st) {
    XcdBarrier b; b.bar = bar; b.x = xb_xcc_id(); b.st = st;
    if (threadIdx.x == 0) (void)xb_add(&bar[XB_XCNT(b.x)], 1u);
    return b;
}
__device__ __forceinline__ void xcd_barrier_complete(unsigned* bar, unsigned x, unsigned& nloc, unsigned& nx) {
    const unsigned G = gridDim.x * gridDim.y * gridDim.z;
    unsigned sum, cnt, mine, sp = 0u;
    for (;;) {
        sum = 0u; cnt = 0u; mine = 0u;
#pragma unroll
        for (unsigned j = 0; j < 16; ++j) { const unsigned c = xb_ld(&bar[XB_XCNT(j)]); sum += c; cnt += (c > 0u) ? 1u : 0u; mine = (j == x) ? c : mine; }
        if (sum == G) break;
        __builtin_amdgcn_s_sleep(1);
        if ((++sp & 255u) == 0u) { if (xb_ld(&bar[XB_TMO])) break; if (sp > XB_SPIN_CAP) { atomicAdd(&bar[XB_TMO], 1u); break; } }
    }
    nloc = mine > 0u ? mine : 1u; nx = cnt > 0u ? cnt : 1u;
}
__device__ __forceinline__ void xcd_barrier(const XcdBarrier& b) {
    asm volatile("s_waitcnt vmcnt(0)" ::: "memory");
    __syncthreads();
    if (threadIdx.x == 0) {
        unsigned* bar = b.bar;
        __builtin_amdgcn_s_waitcnt(0);
        unsigned nloc = b.st[0], nx = b.st[1];
        if (nloc == 0u) { xcd_barrier_complete(bar, b.x, nloc, nx); b.st[0] = nloc; b.st[1] = nx; }
        const unsigned old = xb_add(&bar[XB_XSUB(b.x)], 1u);
        const unsigned gen = old / nloc;
        if (old + 1u == (gen + 1u) * nloc) {
            __builtin_amdgcn_fence(__ATOMIC_RELEASE, "agent");
            asm volatile("s_waitcnt vmcnt(0)" ::: "memory");
            const unsigned og = xb_add(&bar[XB_TOP], 1u);
            const unsigned tg = og / nx;
            if (og + 1u == (tg + 1u) * nx) xb_add(&bar[XB_TOPGEN], 1u);
            else XB_SPIN(xb_ld(&bar[XB_TOPGEN]) == tg, bar);
            __builtin_amdgcn_fence(__ATOMIC_ACQUIRE, "agent");
            xb_add(&bar[XB_XGEN(b.x)], 1u);
            asm volatile("s_waitcnt vmcnt(0)" ::: "memory");
        } else {
            XB_SPIN(xb_ld(&bar[XB_XGEN(b.x)]) == gen, bar);
            __builtin_amdgcn_fence(__ATOMIC_ACQUIRE, "agent");
            asm volatile("s_waitcnt vmcnt(0)" ::: "memory");
        }
    }
    __syncthreads();
}

struct Frame {
    LAS unsigned char* lds;
    int tid, lane, wave, G, gw, ngw;
    unsigned char* ws;
};
struct Args { const float* in[24]; float* out; unsigned char* ws; int ph_lo, ph_hi; };
#define WSP(T, off) ((T*)(F.ws + (off)))
__device__ __forceinline__ bf16* wptr(const Frame& F, int l, size_t off) { return (bf16*)(F.ws + WS_W) + (size_t)l * W_LAYER_E + off; }
__device__ __forceinline__ const float* modp(const Frame& F, int l, int bidx, int k) { return (const float*)(F.ws + WS_MOD) + ((size_t)(l * 5 + bidx) * NMOD + k) * D; }

__device__ __forceinline__ int opqv(int v) { asm volatile("" : "+v"(v)); return v; }
__device__ __forceinline__ int opqs(int v) { asm volatile("" : "+s"(v)); return v; }
#define PH_IDS const int tid = opqv(F.tid), lane = tid & 63, wave = opqs(F.wave), gw = blockIdx.x * NWAVES + wave, ngw = F.G * NWAVES; (void)tid; (void)lane; (void)wave; (void)gw; (void)ngw
__device__ __forceinline__ void transpose_item(const float* W, int N, int ldk, bf16* WT, int k0, int nsrc0, int ndst0, LAS float* scr, int lane) {
    float tv[32];
#pragma unroll
    for (int i = 0; i < 32; ++i) { const int kk = 2 * i + (lane >> 5); tv[i] = W[(size_t)(k0 + kk) * N + nsrc0 + (lane & 31)]; }
#pragma unroll
    for (int i = 0; i < 32; ++i) { const int kk = 2 * i + (lane >> 5); scr[kk * 33 + (lane & 31)] = tv[i]; }
    LDS_WAIT(); asm volatile("" ::: "memory");
    const int c = lane & 7;
#pragma unroll
    for (int j = 0; j < 4; ++j) { const int n = (lane >> 3) + 8 * j; const LAS float* s = scr + (8 * c) * 33 + n;
        v4u o; o.x = pk2(s[0 * 33], s[1 * 33]); o.y = pk2(s[2 * 33], s[3 * 33]); o.z = pk2(s[4 * 33], s[5 * 33]); o.w = pk2(s[6 * 33], s[7 * 33]);
        *(v4u*)(WT + (size_t)(ndst0 + n) * ldk + k0 + 8 * c) = o; }
    LDS_WAIT(); asm volatile("" ::: "memory");
}
constexpr int I_UP = 32 * 352, I_DN = 88 * 64, I_IN = 32 * 320, I_BA = 8 * 64, I_BC = 16 * 64, I_OUT = 32 * 64;
constexpr int I_LAYER = 2 * I_UP + 2 * I_DN + I_IN + 2 * I_BA + I_BC + I_OUT;
__device__ __forceinline__ void conv_item(const Args& args, Frame& F, int l, int r, LAS float* scr, int lane) {
    const float* src; bf16* dst; int N, K; bool up = false; int ldk = 0;
    if (r < 2 * I_UP) { const int f = r / I_UP; r %= I_UP; src = args.in[7] + (size_t)(l * 2 + f) * D * 2 * FFN; dst = wptr(F, l, WO_UP + f * W_UP_E); N = 2 * FFN; K = D; up = true; }
    else if ((r -= 2 * I_UP) < 2 * I_DN) { const int f = r / I_DN; r %= I_DN; src = args.in[8] + (size_t)(l * 2 + f) * FFN * D; dst = wptr(F, l, WO_DN + f * W_DN_E); N = D; K = FFN; }
    else if ((r -= 2 * I_DN) < I_IN) { src = args.in[9] + (size_t)l * D * INC; dst = wptr(F, l, WO_IN); N = INC; K = D; }
    else if ((r -= I_IN) < I_BA) { src = args.in[20] + (size_t)l * 512 * D; dst = wptr(F, l, WO_BRA); N = D; K = 512; ldk = D; }
    else if ((r -= I_BA) < I_BA) { src = args.in[21] + (size_t)l * 512 * D; dst = wptr(F, l, WO_BRA) + 512; N = D; K = 512; ldk = D; }
    else if ((r -= I_BA) < I_BC) { src = args.in[22] + (size_t)l * 1024 * D; dst = wptr(F, l, WO_BRA) + 1024; N = D; K = 1024; ldk = D; }
    else { r -= I_BC; src = args.in[23] + (size_t)l * D * D; dst = wptr(F, l, WO_OUT); N = D; K = D; }
    const int nblk = N / 32, kb = r / nblk, nb = r % nblk, ndst0 = 32 * nb;
    int nsrc0 = ndst0;
    if (up) { const int pn = ndst0 >> 8, w = ndst0 & 255; nsrc0 = (w >> 7) * FFN + 128 * pn + (w & 127); }
    transpose_item(src, N, ldk ? ldk : K, dst, 64 * kb, nsrc0, ndst0, scr, lane);
}
__device__ __forceinline__ void conv_slot(const Args& args, Frame& F, int i0, int cnt, int j, int nj) {
    PH_IDS;
    if (j < 0 || j >= nj) return;
    LAS float* scr = (LAS float*)(F.lds + wave * 16384);
    for (int it = i0 + j * NWAVES + wave; it < i0 + cnt; it += nj * NWAVES) conv_item(args, F, 1, it, scr, lane);
    __syncthreads();
}
constexpr int CS_UP1 = 6400, CS_DN1 = 7680, CS_IN = 7680, CS_MRG = 19712, CS_UP2 = 6400, CS_ALL = CS_UP1 + CS_DN1 + CS_IN + CS_MRG + CS_UP2;
static_assert(CS_ALL <= I_LAYER, "conversion slots");
__device__ __forceinline__ void phase_prologue(const Args& args, Frame& F) {
    PH_IDS;
    LAS float* scr = (LAS float*)(F.lds + wave * 16384);
    for (int it = gw; it < I_LAYER + (I_LAYER - CS_ALL); it += ngw) { if (it < I_LAYER) conv_item(args, F, 0, it, scr, lane); else conv_item(args, F, 1, CS_ALL + (it - I_LAYER), scr, lane); }
    for (int l = 0; l < 2; ++l) {
        bf16* dst = wptr(F, l, WO_LR); const float* w1 = args.in[13] + (size_t)l * 2 * D * 16;
        for (int i = blockIdx.x * 512 + tid; i < 32 * D; i += F.G * 512) { const int n = i / D, k = i % D;
            dst[i] = (bf16)f2bf(w1[((size_t)(n >> 4) * D + k) * 16 + (n & 15)]); }
    }
    __syncthreads();
    LAS float* cact = (LAS float*)F.lds;
    LAS float* red = (LAS float*)(F.lds + 40960);
    for (int i = tid; i < 5 * D; i += 512) { const int b = i / D, k = i % D; const float v = b < 4 ? args.in[1][b * D + k] : args.in[3][k]; cact[i] = silu_f(v); }
    __syncthreads();
    for (int u = blockIdx.x; u < 256; u += F.G) {
        const int l = u >> 7, cb = (u & 127) * 144;
        if (tid < 504) {
            const int cg = tid % 36, ks = tid / 36, k0 = ks * 147, k1 = (k0 + 147) < D ? (k0 + 147) : D;
            f32x4 a0 = {0, 0, 0, 0}, a1 = a0, a2 = a0, a3 = a0, a4 = a0;
            const float* wp = args.in[4] + (size_t)l * D * (NMOD * D) + cb + cg * 4;
#pragma unroll 4
            for (int k = k0; k < k1; ++k) { const f32x4 w = *(const f32x4*)(wp + (size_t)k * (NMOD * D));
                a0 += cact[k] * w; a1 += cact[D + k] * w; a2 += cact[2 * D + k] * w; a3 += cact[3 * D + k] * w; a4 += cact[4 * D + k] * w; }
            LAS float* rp = red + ks * 720 + cg * 4;
#pragma unroll
            for (int j = 0; j < 4; ++j) { rp[j] = a0[j]; rp[144 + j] = a1[j]; rp[288 + j] = a2[j]; rp[432 + j] = a3[j]; rp[576 + j] = a4[j]; }
        }
        __syncthreads();
        for (int idx = tid; idx < 720; idx += 512) { const int i = idx / 144, cc = idx % 144; float s = 0.f;
#pragma unroll
            for (int ks = 0; ks < 14; ++ks) s += red[ks * 720 + idx];
            s += args.in[5][(size_t)l * NMOD * D + cb + cc];
            ((float*)(F.ws + WS_MOD))[(size_t)(l * 5 + i) * NMOD * D + cb + cc] = s; }
        __syncthreads();
    }
}

template <int NS> __device__ __forceinline__ void phase_norm(const Args& args, Frame& F, int l, int which, bool first, int nrows, const float* pgate, float pscale) {
    PH_IDS;
    float* xbuf = WSP(float, WS_XBUF); bf16* HA = WSP(bf16, WS_HA);
    const float* gain = args.in[6] + (size_t)(l * 3 + which) * D;
    for (int row = gw; row < nrows; row += ngw) {
        const float* src = first ? (row < ML ? args.in[0] + (size_t)row * D : args.in[2] + (size_t)(row - ML) * D) : xbuf + (size_t)row * D;
        const int bidx = row < ML ? (row >> 12) : 4;
        const float* sh = modp(F, l, bidx, 3 * which), * sc = modp(F, l, bidx, 3 * which + 1);
        f32x4 v[8]; float ss = 0.f;
#pragma unroll
        for (int j = 0; j < 8; ++j) v[j] = ((const f32x4*)src)[lane + 64 * j];
        const bool upd = (pgate != nullptr) && row >= ML;
        if (upd) { const float* pp = WSP(float, WS_PART) + (size_t)(row - ML) * D;
#pragma unroll
            for (int j = 0; j < 8; ++j) { f32x4 pa[NS];
#pragma unroll
                for (int ks = 0; ks < NS; ++ks) pa[ks] = ((const f32x4*)(pp + (size_t)ks * MC * D))[lane + 64 * j];
                f32x4 a = pa[0];
#pragma unroll
                for (int ks = 1; ks < NS; ++ks) a += pa[ks];
                v[j] += pscale * ((const f32x4*)pgate)[lane + 64 * j] * a; } }
#pragma unroll
        for (int j = 0; j < 8; ++j) ss += (v[j].x * v[j].x + v[j].y * v[j].y) + (v[j].z * v[j].z + v[j].w * v[j].w);
        const float rstd = rsqrtf(wave_sum(ss) * (1.f / D) + EPS);
        if ((first && row >= ML) || upd) {
#pragma unroll
            for (int j = 0; j < 8; ++j) ((f32x4*)(xbuf + (size_t)row * D))[lane + 64 * j] = v[j];
        }
#pragma unroll
        for (int j = 0; j < 8; ++j) { const int c4 = lane + 64 * j;
            const f32x4 g = ((const f32x4*)gain)[c4], s1 = ((const f32x4*)sc)[c4], s0 = ((const f32x4*)sh)[c4];
            const f32x4 h = v[j] * rstd * g * (1.f + s1) + s0;
            v2u o; o.x = pk2(h.x, h.y); o.y = pk2(h.z, h.w);
            ((v2u*)(HA + (size_t)row * D))[c4] = o; }
    }
}

__device__ __forceinline__ void lr_block(const Args& args, Frame& F, int l, int rb) {
    PH_IDS;
    const bf16* HA = WSP(bf16, WS_HA); const bf16* W = wptr(F, l, WO_LR); float* LR = WSP(float, WS_LR);
    const int fr = lane & 15, fq = lane >> 4, k0 = 256 * wave;
    f32x4 acc[4][2];
#pragma unroll
    for (int mt = 0; mt < 4; ++mt) { acc[mt][0] = (f32x4){0.f, 0.f, 0.f, 0.f}; acc[mt][1] = acc[mt][0]; }
#pragma unroll 2
    for (int ks = 0; ks < 8; ++ks) { const int k = k0 + 32 * ks + 8 * fq;
        const bf16x8 b0 = *(const bf16x8*)(W + (size_t)fr * D + k), b1 = *(const bf16x8*)(W + (size_t)(16 + fr) * D + k);
#pragma unroll
        for (int mt = 0; mt < 4; ++mt) { const bf16x8 a = *(const bf16x8*)(HA + (size_t)(64 * rb + 16 * mt + fr) * D + k);
            acc[mt][0] = MFMA16(b0, a, acc[mt][0]); acc[mt][1] = MFMA16(b1, a, acc[mt][1]); } }
    LAS float* part = (LAS float*)F.lds;
#pragma unroll
    for (int mt = 0; mt < 4; ++mt)
#pragma unroll
        for (int nt = 0; nt < 2; ++nt) *(LAS f32x4*)(part + wave * 2048 + (16 * mt + fr) * 32 + 16 * nt + 4 * fq) = acc[mt][nt];
    __syncthreads();
    { f32x4 a = *(const LAS f32x4*)(part + tid * 4);
#pragma unroll
      for (int w = 1; w < 8; ++w) a += *(const LAS f32x4*)(part + w * 2048 + tid * 4);
      *(f32x4*)(LR + (size_t)64 * rb * 32 + tid * 4) = a; }
    __syncthreads();
}

__device__ __forceinline__ void phase_prep(const Args& args, Frame& F, int l) {
    PH_IDS;
    const bf16* Z = WSP(bf16, WS_Z); bf16* QN = WSP(bf16, WS_QN); bf16* KN = WSP(bf16, WS_KN); bf16* VN = WSP(bf16, WS_VN);
    const float* qg = args.in[17] + l * 128, * kg = args.in[18] + l * 128, * avg = args.in[10] + l * 512;
    const int hsel = lane >> 5, j5 = lane & 31, hs = j5 >> 4, f0 = (j5 & 15) * 2;
    const int d1 = hs * 64 + f0, d2 = d1 + 32;
    const float invf0 = __powf(10000.f, -(float)f0 * (1.f / 32.f)), invf1 = __powf(10000.f, -(float)(f0 + 1) * (1.f / 32.f));
    const float gq1a = qg[d1], gq1b = qg[d1 + 1], gq2a = qg[d2], gq2b = qg[d2 + 1], gk1a = kg[d1], gk1b = kg[d1 + 1], gk2a = kg[d2], gk2b = kg[d2 + 1];
    unsigned nu1[5], nu2[5]; v4u nraw;
#define PREP_LOAD(r) do { const bf16* _z = Z + (size_t)(r) * INC; _Pragma("unroll") for (int it = 0; it < 5; ++it) { const bf16* _s = it < 4 ? _z + COL_CQ + (2 * it + hsel) * 128 : _z + COL_CK + hsel * 128; \
        nu1[it] = *(const unsigned*)(_s + d1); nu2[it] = *(const unsigned*)(_s + d2); } nraw = *(const v4u*)(_z + COL_AV + lane * 8); } while (0)
    if (gw < MT) PREP_LOAD(gw);
    for (int row = gw; row < MT; row += ngw) {
        unsigned u1[5], u2[5];
#pragma unroll
        for (int it = 0; it < 5; ++it) { u1[it] = nu1[it]; u2[it] = nu2[it]; }
        const v4u raw = nraw;
        if (row + ngw < MT) PREP_LOAD(row + ngw);
        float cs0 = 1.f, sn0 = 0.f, cs1 = 1.f, sn1 = 0.f;
        if (row < ML) { const int t = row & 4095; const float pos = (float)(hs ? (t & 63) : (t >> 6)); cs0 = __cosf(pos * invf0); sn0 = __sinf(pos * invf0); cs1 = __cosf(pos * invf1); sn1 = __sinf(pos * invf1); }
#pragma unroll
        for (int it = 0; it < 5; ++it) {
            const float x1a = blo(u1[it]), x1b = bhi(u1[it]), x2a = blo(u2[it]), x2b = bhi(u2[it]);
            float ss = (x1a * x1a + x1b * x1b) + (x2a * x2a + x2b * x2b);
            ss += __shfl_xor(ss, 1); ss += __shfl_xor(ss, 2); ss += __shfl_xor(ss, 4); ss += __shfl_xor(ss, 8); ss += __shfl_xor(ss, 16);
            const float rstd = rsqrtf(ss * (1.f / 128.f) + EPS);
            const float y1a = x1a * rstd * (it < 4 ? gq1a : gk1a), y1b = x1b * rstd * (it < 4 ? gq1b : gk1b), y2a = x2a * rstd * (it < 4 ? gq2a : gk2a), y2b = x2b * rstd * (it < 4 ? gq2b : gk2b);
            float o1a = y1a * cs0 - y2a * sn0, o2a = y1a * sn0 + y2a * cs0, o1b = y1b * cs1 - y2b * sn1, o2b = y1b * sn1 + y2b * cs1;
            if (it < 4) { o1a *= 0.12751743074602112f; o2a *= 0.12751743074602112f; o1b *= 0.12751743074602112f; o2b *= 0.12751743074602112f; }
            bf16* dst = it < 4 ? QN + (size_t)row * 1024 + (2 * it + hsel) * 128 : KN + (size_t)row * 256 + hsel * 128;
            *(unsigned*)(dst + d1) = pg8::cvt_pk_bf16(o1a, o1b); *(unsigned*)(dst + d2) = pg8::cvt_pk_bf16(o2a, o2b);
        }
        {
            float e[8] = {blo(raw.x), bhi(raw.x), blo(raw.y), bhi(raw.y), blo(raw.z), bhi(raw.z), blo(raw.w), bhi(raw.w)};
            float s = 0.f;
#pragma unroll
            for (int j = 0; j < 8; ++j) { e[j] = gelu_tanh(e[j]); s += e[j]; }
            const float mu = wave_sum(s) * (1.f / 512.f); float q = 0.f;
#pragma unroll
            for (int j = 0; j < 8; ++j) { e[j] -= mu; q += e[j] * e[j]; }
            const float rstd = rsqrtf(wave_sum(q) * (1.f / 512.f) + EPS);
            const f32x4 g0 = *(const f32x4*)(avg + lane * 8), g1 = *(const f32x4*)(avg + lane * 8 + 4);
            v4u o; o.x = pk2(e[0] * rstd * g0.x, e[1] * rstd * g0.y); o.y = pk2(e[2] * rstd * g0.z, e[3] * rstd * g0.w);
            o.z = pk2(e[4] * rstd * g1.x, e[5] * rstd * g1.y); o.w = pk2(e[6] * rstd * g1.z, e[7] * rstd * g1.w);
            *(v4u*)(VN + (size_t)row * 512 + lane * 8) = o;
        }
    }
}

#undef PREP_LOAD
__device__ __forceinline__ bf16x8 tr_frag(const LAS unsigned char* T, int stride, int i0, int i1, int c0, int fr, int fq) {
    const int off = (4 * fq + (fr >> 2)) * stride + (c0 + 4 * (fr & 3)) * 2;
    const s16x4 a = __builtin_amdgcn_ds_read_tr16_b64_v4i16((LAS s16x4*)(T + off + 16 * i0 * stride));
    const s16x4 b = __builtin_amdgcn_ds_read_tr16_b64_v4i16((LAS s16x4*)(T + off + 16 * i1 * stride));
    return (bf16x8){a[0], a[1], a[2], a[3], b[0], b[1], b[2], b[3]};
}
__device__ __forceinline__ bf16x8 rowp_frag(const LAS unsigned char* R, int stride, int i0, int i1, int r0, int fr, int fq) {
    const LAS unsigned char* p = R + (r0 + fr) * stride + 8 * fq;
    const s16x4 a = *(const LAS s16x4*)(p + 32 * i0), b = *(const LAS s16x4*)(p + 32 * i1);
    return (bf16x8){a[0], a[1], a[2], a[3], b[0], b[1], b[2], b[3]};
}
__device__ __forceinline__ v2u pack4(f32x4 v) { v2u o; o.x = pg8::cvt_pk_bf16(v[0], v[1]); o.y = pg8::cvt_pk_bf16(v[2], v[3]); return o; }
__device__ __forceinline__ v4u pack8(const float* e) { v4u o; o.x = pg8::cvt_pk_bf16(e[0], e[1]); o.y = pg8::cvt_pk_bf16(e[2], e[3]); o.z = pg8::cvt_pk_bf16(e[4], e[5]); o.w = pg8::cvt_pk_bf16(e[6], e[7]); return o; }
__device__ __forceinline__ void unpack8(v4u w, float* e) { e[0] = blo(w.x); e[1] = bhi(w.x); e[2] = blo(w.y); e[3] = bhi(w.y); e[4] = blo(w.z); e[5] = bhi(w.z); e[6] = blo(w.w); e[7] = bhi(w.w); }

__device__ __forceinline__ int gla_row0(int b, int c) { return c < 64 ? b * SEQ + 64 * c : ML + b * CTXL + 64 * (c - 64); }
constexpr int GL_LR = 0, GL_W2 = 8192, GL_BS = 16384, GL_BCF = 16896, GL_BCB = GL_BCF + 64 * 65 * 4, GL_OPS = GL_BCB + 64 * 65 * 4;
__device__ __forceinline__ void gla_gates(const Args& args, LAS unsigned char* lds, int l, int h, int row0, int tid) {
    const float* LR = (const float*)(args.ws + WS_LR);
    const float* w2 = args.in[14] + (size_t)l * 2 * 16 * 256, * db = args.in[15] + (size_t)l * 2 * 256;
    LAS float* lrS = (LAS float*)(lds + GL_LR); LAS float* w2S = (LAS float*)(lds + GL_W2); LAS float* bS = (LAS float*)(lds + GL_BS);
    LAS float* BCF = (LAS float*)(lds + GL_BCF); LAS float* BCB = (LAS float*)(lds + GL_BCB);
    *(LAS f32x4*)(lrS + tid * 4) = *(const f32x4*)(LR + (size_t)row0 * 32 + tid * 4);
    { const int j = tid * 4, dr = j >> 6, dk = j & 63; *(LAS f32x4*)(w2S + j) = *(const f32x4*)(w2 + dr * 256 + h * 64 + dk); }
    if (tid < 128) bS[tid] = db[(tid >> 6) * 256 + h * 64 + (tid & 63)];
    __syncthreads();
    { const int t = tid >> 3, dk0 = (tid & 7) * 8;
      float af[8], ab[8];
#pragma unroll
      for (int j = 0; j < 8; ++j) { af[j] = bS[dk0 + j]; ab[j] = bS[64 + dk0 + j]; }
#pragma unroll 4
      for (int r = 0; r < 16; ++r) { const float l0 = lrS[t * 32 + r], l1 = lrS[t * 32 + 16 + r];
#pragma unroll
          for (int j = 0; j < 8; ++j) { af[j] += l0 * w2S[r * 64 + dk0 + j]; ab[j] += l1 * w2S[(16 + r) * 64 + dk0 + j]; } }
#pragma unroll
      for (int j = 0; j < 8; ++j) { BCF[t * 65 + dk0 + j] = log_sigmoid(af[j]) * (1.f / 16.f); BCB[t * 65 + dk0 + j] = log_sigmoid(ab[j]) * (1.f / 16.f); } }
    __syncthreads();
    {
        const int dk = tid & 63, dir = (tid >> 6) & 1, seg = tid >> 7;
        LAS float* B = dir ? BCB : BCF; LAS float* tot = lrS;
        float v[16];
#pragma unroll
        for (int i = 0; i < 16; ++i) v[i] = B[(16 * seg + i) * 65 + dk];
        if (dir == 0) {
#pragma unroll
            for (int i = 1; i < 16; ++i) v[i] += v[i - 1];
        } else {
#pragma unroll
            for (int i = 14; i >= 0; --i) v[i] += v[i + 1];
        }
        tot[(dir * 4 + seg) * 64 + dk] = dir ? v[0] : v[15];
        __syncthreads();
        float off = 0.f;
#pragma unroll
        for (int s2 = 0; s2 < 4; ++s2) { const float tv = tot[(dir * 4 + s2) * 64 + dk]; off += (dir ? (s2 > seg) : (s2 < seg)) ? tv : 0.f; }
#pragma unroll
        for (int i = 0; i < 16; ++i) B[(16 * seg + i) * 65 + dk] = v[i] + off;
    }
    __syncthreads();
}
constexpr int G1_KOF = GL_OPS, G1_KOB = G1_KOF + 64 * 144, G1_V = G1_KOB + 64 * 144, G1_END = G1_V + 64 * 272;
__device__ __forceinline__ void gla1_unit(const Args& args, Frame& F, int l, int u) {
    PH_IDS;
    LAS unsigned char* lds = F.lds;
    const int h = u & 3, bc = u >> 2, b = bc / 68, c = bc % 68, row0 = gla_row0(b, c);
    const bf16* Z = (const bf16*)(args.ws + WS_Z);
    const int t = tid >> 3, dk0 = (tid & 7) * 8, c16 = (tid & 7) * 16;
    const bf16* zr = Z + (size_t)(row0 + t) * INC;
    const v4u kraw = *(const v4u*)(zr + COL_BK + h * 64 + dk0), vraw0 = *(const v4u*)(zr + COL_BV + h * 128 + c16), vraw1 = *(const v4u*)(zr + COL_BV + h * 128 + c16 + 8);
    gla_gates(args, lds, l, h, row0, tid);
    const LAS float* BCF = (const LAS float*)(lds + GL_BCF); const LAS float* BCB = (const LAS float*)(lds + GL_BCB);
    { float k[8], of[8], ob[8]; unpack8(kraw, k);
#pragma unroll
      for (int j = 0; j < 8; ++j) { of[j] = k[j] * __expf(BCF[63 * 65 + dk0 + j] - BCF[t * 65 + dk0 + j]); ob[j] = k[j] * __expf(BCB[dk0 + j] - BCB[t * 65 + dk0 + j]); }
      *(LAS v4u*)(lds + G1_KOF + t * 144 + dk0 * 2) = pack8(of); *(LAS v4u*)(lds + G1_KOB + t * 144 + dk0 * 2) = pack8(ob);
      *(LAS v4u*)(lds + G1_V + t * 272 + c16 * 2) = vraw0;
      *(LAS v4u*)(lds + G1_V + t * 272 + c16 * 2 + 16) = vraw1; }
    if (tid < 128) { const int dir = tid >> 6, dk = tid & 63;
        ((float*)(args.ws + WS_DEC))[((size_t)((b * 4 + h) * 2 + dir) * 68 + c) * 64 + dk] = __expf(dir ? BCB[dk] : BCF[63 * 65 + dk]); }
    __syncthreads();
    { const int fr = lane & 15, fq = lane >> 4, dir = wave >> 2, kt = wave & 3;
      const LAS unsigned char* KO = lds + (dir ? G1_KOB : G1_KOF);
      f32x4 acc[8];
#pragma unroll
      for (int nt = 0; nt < 8; ++nt) acc[nt] = (f32x4){0.f, 0.f, 0.f, 0.f};
#pragma unroll
      for (int ks = 0; ks < 2; ++ks) { const bf16x8 y = tr_frag(KO, 144, 2 * ks, 2 * ks + 1, 16 * kt, fr, fq);
#pragma unroll
          for (int nt = 0; nt < 8; ++nt) { const bf16x8 x = tr_frag(lds + G1_V, 272, 2 * ks, 2 * ks + 1, 16 * nt, fr, fq); acc[nt] = MFMA16(x, y, acc[nt]); } }
      float* st = (float*)(args.ws + WS_ST) + ((size_t)((b * 4 + h) * 2 + dir) * 68 + c) * 8192 + (size_t)(16 * kt + fr) * 128 + 4 * fq;
#pragma unroll
      for (int nt = 0; nt < 8; ++nt) *(f32x4*)(st + 16 * nt) = acc[nt]; }
    __syncthreads();
}
__device__ __forceinline__ void gla_scan(const Args& args, Frame& F) {
    PH_IDS;
    float* ST = (float*)(args.ws + WS_ST); const float* DEC = (const float*)(args.ws + WS_DEC);
    for (int e = blockIdx.x * 512 + tid; e < 32 * 4096; e += F.G * 512) {
        const int chain = e >> 12, idx = (e & 4095) * 2, dk = idx >> 7, dir = chain & 1;
        float* base = ST + (size_t)chain * 68 * 8192 + idx; const float* dbase = DEC + (size_t)chain * 68 * 64 + dk;
        float sx = 0.f, sy = 0.f;
        for (int s0 = 0; s0 < 68; s0 += 8) {
            float kx[8], ky[8], d[8]; int cc[8];
#pragma unroll
            for (int i = 0; i < 8; ++i) { const int s = s0 + i; cc[i] = s < 4 ? (dir ? 67 - s : 64 + s) : (dir ? 67 - s : s - 4);
                if (s < 68) { const float2 v = *(const float2*)(base + (size_t)cc[i] * 8192); kx[i] = v.x; ky[i] = v.y; d[i] = dbase[cc[i] * 64]; } else { kx[i] = 0.f; ky[i] = 0.f; d[i] = 1.f; } }
#pragma unroll
            for (int i = 0; i < 8; ++i) if (s0 + i < 68) { *(float2*)(base + (size_t)cc[i] * 8192) = make_float2(sx, sy); sx = sx * d[i] + kx[i]; sy = sy * d[i] + ky[i]; }
        }
    }
}
constexpr int G3_QF = GL_OPS, G3_QB = G3_QF + 64 * 144, G3_KF = G3_QB + 64 * 144, G3_KB = G3_KF + 64 * 144, G3_V = G3_KB + 64 * 144, G3_SF = G3_V + 64 * 272, G3_SB = G3_SF + 64 * 272,
              G3_END = G3_SB + 64 * 272, G3_P = 0  , G3_XS = 9216;
static_assert(G3_END <= LDSCTL_OFF && G3_XS + 512 <= GL_BCF, "GLA-3 LDS map");
__device__ __forceinline__ void gla3_unit(const Args& args, Frame& F, int l, int u) {
    PH_IDS;
    LAS unsigned char* lds = F.lds;
    const int h = u & 3, bc = u >> 2, b = bc / 68, c = bc % 68, row0 = gla_row0(b, c);
    const bf16* Z = (const bf16*)(args.ws + WS_Z); bf16* ABC = (bf16*)(args.ws + WS_ABC);
    const int t = tid >> 3, dk0 = (tid & 7) * 8, c16 = (tid & 7) * 16;
    const bf16* zr = Z + (size_t)(row0 + t) * INC;
    const v4u kraw = *(const v4u*)(zr + COL_BK + h * 64 + dk0), qraw = *(const v4u*)(zr + COL_BQ + h * 64 + dk0), vraw0 = *(const v4u*)(zr + COL_BV + h * 128 + c16), vraw1 = *(const v4u*)(zr + COL_BV + h * 128 + c16 + 8);
    f32x4 sraw[2][4];
#pragma unroll
    for (int dir = 0; dir < 2; ++dir) { const float* sp = (const float*)(args.ws + WS_ST) + ((size_t)((b * 4 + h) * 2 + dir) * 68 + c) * 8192 + (size_t)t * 128 + c16;
#pragma unroll
        for (int i = 0; i < 4; ++i) sraw[dir][i] = *(const f32x4*)(sp + 4 * i); }
    gla_gates(args, lds, l, h, row0, tid);
    const LAS float* BCF = (const LAS float*)(lds + GL_BCF); const LAS float* BCB = (const LAS float*)(lds + GL_BCB);
    { float k[8], q[8], a[8]; unpack8(kraw, k); unpack8(qraw, q);
      float ef[8], eb[8];
#pragma unroll
      for (int j = 0; j < 8; ++j) { ef[j] = __expf(BCF[t * 65 + dk0 + j]); eb[j] = __expf(BCB[t * 65 + dk0 + j]); }
#pragma unroll
      for (int j = 0; j < 8; ++j) a[j] = q[j] * 0.125f * ef[j];
      *(LAS v4u*)(lds + G3_QF + t * 144 + dk0 * 2) = pack8(a);
#pragma unroll
      for (int j = 0; j < 8; ++j) a[j] = q[j] * 0.125f * eb[j];
      *(LAS v4u*)(lds + G3_QB + t * 144 + dk0 * 2) = pack8(a);
#pragma unroll
      for (int j = 0; j < 8; ++j) a[j] = k[j] * __builtin_amdgcn_rcpf(ef[j]);
      *(LAS v4u*)(lds + G3_KF + t * 144 + dk0 * 2) = pack8(a);
#pragma unroll
      for (int j = 0; j < 8; ++j) a[j] = k[j] * __builtin_amdgcn_rcpf(eb[j]);
      *(LAS v4u*)(lds + G3_KB + t * 144 + dk0 * 2) = pack8(a);
      *(LAS v4u*)(lds + G3_V + t * 272 + c16 * 2) = vraw0;
      *(LAS v4u*)(lds + G3_V + t * 272 + c16 * 2 + 16) = vraw1;
#pragma unroll
      for (int dir = 0; dir < 2; ++dir) { const f32x4 s0 = sraw[dir][0], s1 = sraw[dir][1], s2 = sraw[dir][2], s3 = sraw[dir][3];
          v4u w0, w1; w0.x = pg8::cvt_pk_bf16(s0[0], s0[1]); w0.y = pg8::cvt_pk_bf16(s0[2], s0[3]); w0.z = pg8::cvt_pk_bf16(s1[0], s1[1]); w0.w = pg8::cvt_pk_bf16(s1[2], s1[3]);
          w1.x = pg8::cvt_pk_bf16(s2[0], s2[1]); w1.y = pg8::cvt_pk_bf16(s2[2], s2[3]); w1.z = pg8::cvt_pk_bf16(s3[0], s3[1]); w1.w = pg8::cvt_pk_bf16(s3[2], s3[3]);
          LAS unsigned char* dst = lds + (dir ? G3_SB : G3_SF) + t * 272 + c16 * 2; *(LAS v4u*)dst = w0; *(LAS v4u*)(dst + 16) = w1; } }
    __syncthreads();
    const int fr = lane & 15, fq = lane >> 4, tt = wave & 3, wh = wave >> 2;
    {
        f32x4 af[2], ab[2];
#pragma unroll
        for (int i = 0; i < 2; ++i) { af[i] = (f32x4){0.f, 0.f, 0.f, 0.f}; ab[i] = af[i]; }
#pragma unroll
        for (int ks = 0; ks < 2; ++ks) {
            const bf16x8 qf = *(const LAS bf16x8*)(lds + G3_QF + (16 * tt + fr) * 144 + (32 * ks + 8 * fq) * 2), qb = *(const LAS bf16x8*)(lds + G3_QB + (16 * tt + fr) * 144 + (32 * ks + 8 * fq) * 2);
#pragma unroll
            for (int i = 0; i < 2; ++i) { const int st = 2 * wh + i;
                const bf16x8 kf = *(const LAS bf16x8*)(lds + G3_KF + (16 * st + fr) * 144 + (32 * ks + 8 * fq) * 2), kb = *(const LAS bf16x8*)(lds + G3_KB + (16 * st + fr) * 144 + (32 * ks + 8 * fq) * 2);
                af[i] = MFMA16(kf, qf, af[i]); ab[i] = MFMA16(kb, qb, ab[i]); } }
        const int tq = 16 * tt + fr;
#pragma unroll
        for (int i = 0; i < 2; ++i) { const int s0 = 16 * (2 * wh + i) + 4 * fq; f32x4 p;
#pragma unroll
            for (int j = 0; j < 4; ++j) p[j] = (s0 + j <= tq ? af[i][j] : 0.f) + (s0 + j >= tq ? ab[i][j] : 0.f);
            *(LAS v2u*)(lds + G3_P + tq * 144 + s0 * 2) = pack4(p); }
    }
    __syncthreads();
    {
        f32x4 acc[4];
#pragma unroll
        for (int n = 0; n < 4; ++n) acc[n] = (f32x4){0.f, 0.f, 0.f, 0.f};
#pragma unroll
        for (int seg = 0; seg < 3; ++seg) { const LAS unsigned char* Y = lds + (seg == 0 ? G3_P : seg == 1 ? G3_QF : G3_QB); const LAS unsigned char* X = lds + (seg == 0 ? G3_V : seg == 1 ? G3_SF : G3_SB);
#pragma unroll
            for (int ks = 0; ks < 2; ++ks) { const bf16x8 y = rowp_frag(Y, 144, 2 * ks, 2 * ks + 1, 16 * tt, fr, fq);
#pragma unroll
                for (int n = 0; n < 4; ++n) { const bf16x8 x = tr_frag(X, 272, 2 * ks, 2 * ks + 1, 16 * (4 * wh + n), fr, fq); acc[n] = MFMA16(x, y, acc[n]); } } }
        float ss = 0.f;
#pragma unroll
        for (int n = 0; n < 4; ++n) ss += (acc[n][0] * acc[n][0] + acc[n][1] * acc[n][1]) + (acc[n][2] * acc[n][2] + acc[n][3] * acc[n][3]);
        ss += __shfl_xor(ss, 16); ss += __shfl_xor(ss, 32);
        LAS float* XS = (LAS float*)(lds + G3_XS);
        if (fq == 0) XS[(16 * tt + fr) * 2 + wh] = ss;
        __syncthreads();
        const int to = 16 * tt + fr;
        const float rstd = rsqrtf((XS[to * 2] + XS[to * 2 + 1]) * (1.f / 128.f) + EPS);
        const float* gn = args.in[16] + l * 128;
        const bf16* og = Z + (size_t)(row0 + to) * INC + COL_BG + h * 128; bf16* orow = ABC + (size_t)(row0 + to) * D + 512 + h * 128;
#pragma unroll
        for (int n = 0; n < 4; ++n) { const int dv = 16 * (4 * wh + n) + 4 * fq; const f32x4 g = *(const f32x4*)(gn + dv); const v2u ow = *(const v2u*)(og + dv);
            f32x4 y; y[0] = acc[n][0] * rstd * g[0] * silu_f(blo(ow.x)); y[1] = acc[n][1] * rstd * g[1] * silu_f(bhi(ow.x)); y[2] = acc[n][2] * rstd * g[2] * silu_f(blo(ow.y)); y[3] = acc[n][3] * rstd * g[3] * silu_f(bhi(ow.y));
            *(v2u*)(orow + dv) = pack4(y); }
    }
    __syncthreads();
}

constexpr int GM_WS = 0, GM_VN = 128 * 272;
__device__ __forceinline__ void gmlp_unit(const Args& args, Frame& F, int l, int u) {
    PH_IDS;
    LAS unsigned char* lds = F.lds;
    const int g = u & 3, r0 = (u >> 2) * 128;
    const bf16* Z = (const bf16*)(args.ws + WS_Z); const bf16* VN = (const bf16*)(args.ws + WS_VN); bf16* ABC = (bf16*)(args.ws + WS_ABC);
    const float* ws = args.in[11] + ((size_t)l * 4 + g) * 128 * 128, * bs = args.in[12] + ((size_t)l * 4 + g) * 128;
    { const int p = tid >> 2, q0 = (tid & 3) * 32;
#pragma unroll
      for (int i = 0; i < 4; ++i) { const f32x4 a = *(const f32x4*)(ws + p * 128 + q0 + 8 * i), b2 = *(const f32x4*)(ws + p * 128 + q0 + 8 * i + 4);
          v4u w; w.x = pg8::cvt_pk_bf16(a[0], a[1]); w.y = pg8::cvt_pk_bf16(a[2], a[3]); w.z = pg8::cvt_pk_bf16(b2[0], b2[1]); w.w = pg8::cvt_pk_bf16(b2[2], b2[3]);
          *(LAS v4u*)(lds + GM_WS + p * 272 + (q0 + 8 * i) * 2) = w;
          *(LAS v4u*)(lds + GM_VN + p * 272 + (q0 + 8 * i) * 2) = *(const v4u*)(VN + (size_t)(r0 + p) * 512 + g * 128 + q0 + 8 * i); } }
    __syncthreads();
    { const int fr = lane & 15, fq = lane >> 4, p0 = 16 * wave;
      f32x4 acc[8];
#pragma unroll
      for (int nt = 0; nt < 8; ++nt) acc[nt] = (f32x4){0.f, 0.f, 0.f, 0.f};
#pragma unroll
      for (int ks = 0; ks < 4; ++ks) { const bf16x8 y = rowp_frag(lds + GM_WS, 272, 2 * ks, 2 * ks + 1, p0, fr, fq);
#pragma unroll
          for (int nt = 0; nt < 8; ++nt) { const bf16x8 x = tr_frag(lds + GM_VN, 272, 2 * ks, 2 * ks + 1, 16 * nt, fr, fq); acc[nt] = MFMA16(x, y, acc[nt]); } }
      const int p = p0 + fr; const float bias = bs[p];
      const bf16* ur = Z + (size_t)(r0 + p) * INC + COL_AU + g * 128; bf16* orow = ABC + (size_t)(r0 + p) * D + g * 128;
#pragma unroll
      for (int nt = 0; nt < 8; ++nt) { const int d = 16 * nt + 4 * fq; const v2u uw = *(const v2u*)(ur + d);
          f32x4 y; y[0] = gelu_tanh(blo(uw.x)) * (acc[nt][0] + bias); y[1] = gelu_tanh(bhi(uw.x)) * (acc[nt][1] + bias); y[2] = gelu_tanh(blo(uw.y)) * (acc[nt][2] + bias); y[3] = gelu_tanh(bhi(uw.y)) * (acc[nt][3] + bias);
          *(v2u*)(orow + d) = pack4(y); } }
    __syncthreads();
}

constexpr int AT_K0 = 0, AT_V0 = 2 * 64 * 272, AT_TILE = 64 * 272;
__device__ __forceinline__ void attn_unit(const Args& args, Frame& F, int l, int u) {
    PH_IDS;
    LAS unsigned char* lds = F.lds;
    const bf16* Z = (const bf16*)(args.ws + WS_Z); const bf16* QN = (const bf16*)(args.ws + WS_QN); const bf16* KN = (const bf16*)(args.ws + WS_KN); bf16* ABC = (bf16*)(args.ws + WS_ABC);
    int b, kvh, qb, qrow0, jlo, nloc;
    if (u < 512) { b = u >> 7; kvh = (u >> 6) & 1; qb = u & 63; qrow0 = b * SEQ + 64 * qb; jlo = qb - 2 < 0 ? 0 : qb - 2; const int jhi = qb + 2 > 63 ? 63 : qb + 2; nloc = jhi - jlo + 1; }
    else { const int cu = u - 512; b = cu >> 3; kvh = (cu >> 2) & 1; qb = cu & 3; qrow0 = ML + b * CTXL + 64 * qb; jlo = 0; nloc = 0; }
    const int ntl = nloc + 4;
    const int fr = lane & 15, fq = lane >> 4, h = kvh * 4 + (wave >> 1), qoff = (wave & 1) * 32;
    bf16x8 bq[2][4];
#pragma unroll
    for (int qt = 0; qt < 2; ++qt)
#pragma unroll
        for (int ks = 0; ks < 4; ++ks) bq[qt][ks] = *(const bf16x8*)(QN + (size_t)(qrow0 + qoff + 16 * qt + fr) * 1024 + h * 128 + 32 * ks + 8 * fq);
    const float sink = args.in[19][l * 8 + h] * 1.4426950408889634f;
    float mrun[2] = {sink, sink}, lsum[2] = {1.f, 1.f};
    f32x4 o[8][2];
#pragma unroll
    for (int nt = 0; nt < 8; ++nt) { o[nt][0] = (f32x4){0.f, 0.f, 0.f, 0.f}; o[nt][1] = o[nt][0]; }
    v4u rk[2], rv[2];
    const int srow = tid >> 4, sch = (tid & 15) * 8;
#define AT_LOAD(i) do { const int _r0 = (i) < nloc ? b * SEQ + 64 * (jlo + (i)) : ML + b * CTXL + 64 * ((i) - nloc); \
        _Pragma("unroll") for (int _j = 0; _j < 2; ++_j) { const size_t _r = (size_t)(_r0 + srow + 32 * _j); rk[_j] = *(const v4u*)(KN + _r * 256 + kvh * 128 + sch); rv[_j] = *(const v4u*)(Z + _r * INC + COL_CV + kvh * 128 + sch); } } while (0)
#define AT_STORE(buf) do { _Pragma("unroll") for (int _j = 0; _j < 2; ++_j) { *(LAS v4u*)(lds + AT_K0 + (buf) * AT_TILE + (srow + 32 * _j) * 272 + sch * 2) = rk[_j]; *(LAS v4u*)(lds + AT_V0 + (buf) * AT_TILE + (srow + 32 * _j) * 272 + sch * 2) = rv[_j]; } } while (0)
    AT_LOAD(0); AT_STORE(0);
    __syncthreads();
    for (int i = 0; i < ntl; ++i) {
        if (i + 1 < ntl) AT_LOAD(i + 1);
        const LAS unsigned char* Kb = lds + AT_K0 + (i & 1) * AT_TILE; const LAS unsigned char* Vb = lds + AT_V0 + (i & 1) * AT_TILE;
        f32x4 s[4][2];
#pragma unroll
        for (int kt = 0; kt < 4; ++kt) { s[kt][0] = (f32x4){0.f, 0.f, 0.f, 0.f}; s[kt][1] = s[kt][0]; }
#pragma unroll
        for (int ks = 0; ks < 4; ++ks)
#pragma unroll
            for (int kt = 0; kt < 4; ++kt) { const bf16x8 a = *(const LAS bf16x8*)(Kb + (16 * kt + fr) * 272 + (32 * ks + 8 * fq) * 2);
                s[kt][0] = MFMA16(a, bq[0][ks], s[kt][0]); s[kt][1] = MFMA16(a, bq[1][ks], s[kt][1]); }
        if (i < nloc) { const int jt = jlo + i;
            if (jt == qb - 2 || jt == qb + 2) {
#pragma unroll
                for (int qt = 0; qt < 2; ++qt) { const int qpos = 64 * qb + qoff + 16 * qt + fr;
#pragma unroll
                    for (int kt = 0; kt < 4; ++kt)
#pragma unroll
                        for (int j = 0; j < 4; ++j) { const int dlt = qpos - (64 * jt + 16 * kt + 4 * fq + j); if (dlt > 128 || dlt < -128) s[kt][qt][j] = -__builtin_inff(); } } } }
        bf16x8 pf[2][2];
#pragma unroll
        for (int qt = 0; qt < 2; ++qt) {
            float mx = s[0][qt][0];
#pragma unroll
            for (int kt = 0; kt < 4; ++kt)
#pragma unroll
                for (int j = 0; j < 4; ++j) mx = fmaxf(mx, s[kt][qt][j]);
            mx = fmaxf(mx, __shfl_xor(mx, 16)); mx = fmaxf(mx, __shfl_xor(mx, 32));
            if (__any(mx - mrun[qt] > 8.f)) {
                const float mn = fmaxf(mrun[qt], mx), alpha = __builtin_amdgcn_exp2f(mrun[qt] - mn); mrun[qt] = mn; lsum[qt] *= alpha;
#pragma unroll
                for (int nt = 0; nt < 8; ++nt) o[nt][qt] *= alpha; }
            const float mref = mrun[qt]; float rs = 0.f;
#pragma unroll
            for (int kt = 0; kt < 4; ++kt)
#pragma unroll
                for (int j = 0; j < 4; ++j) { const float p = __builtin_amdgcn_exp2f(s[kt][qt][j] - mref); s[kt][qt][j] = p; rs += p; }
            rs += __shfl_xor(rs, 16); rs += __shfl_xor(rs, 32);
            lsum[qt] += rs;
#pragma unroll
            for (int kp = 0; kp < 2; ++kp) { const v2u lo = pack4(s[2 * kp][qt]), hi = pack4(s[2 * kp + 1][qt]); const v4u w = {lo.x, lo.y, hi.x, hi.y}; pf[qt][kp] = __builtin_bit_cast(bf16x8, w); }
        }
#pragma unroll
        for (int kp = 0; kp < 2; ++kp)
#pragma unroll
            for (int nt = 0; nt < 8; ++nt) { const bf16x8 x = tr_frag(Vb, 272, 2 * kp, 2 * kp + 1, 16 * nt, fr, fq);
                o[nt][0] = MFMA16(x, pf[0][kp], o[nt][0]); o[nt][1] = MFMA16(x, pf[1][kp], o[nt][1]); }
        if (i + 1 < ntl) AT_STORE((i + 1) & 1);
        __syncthreads();
    }
#undef AT_LOAD
#undef AT_STORE
#pragma unroll
    for (int qt = 0; qt < 2; ++qt) { const float inv = 1.f / lsum[qt]; bf16* orow = ABC + (size_t)(qrow0 + qoff + 16 * qt + fr) * D + 1024 + h * 128 + 4 * fq;
#pragma unroll
        for (int nt = 0; nt < 8; ++nt) *(v2u*)(orow + 16 * nt) = pack4(o[nt][qt] * inv); }
}

constexpr int NPL = 13, NPH = 1 + 2 * NPL;
__global__ void __launch_bounds__(NWAVES * 64, 2) fwd_kernel(Args args) {
    extern __shared__ __attribute__((aligned(16))) unsigned char lds[];
    Frame F;
    F.lds = (LAS unsigned char*)lds;
    F.tid = threadIdx.x; F.lane = F.tid & 63; F.wave = __builtin_amdgcn_readfirstlane(F.tid >> 6);
    F.G = gridDim.x; F.gw = blockIdx.x * NWAVES + F.wave; F.ngw = F.G * NWAVES;
    F.ws = args.ws;
    volatile LAS unsigned* MISC = (volatile LAS unsigned*)(F.lds + MISC_OFF);
    for (int u = F.tid; u < (LDS_BYTES - LDSCTL_OFF) / 4; u += NWAVES * 64) ((LAS unsigned*)(F.lds + LDSCTL_OFF))[u] = 0u;
    __syncthreads();
    const int lo = args.ph_lo, hi = args.ph_hi;
    XcdBarrier bar; bar.bar = (unsigned*)(F.ws + WS_CTL) + CW_BAR; bar.x = 0; bar.st = nullptr;
    if (hi - lo > 1) bar = xcd_barrier_post((unsigned*)(F.ws + WS_CTL) + CW_BAR, MISC + 8);
#ifndef PHMASK
#define PHMASK 0xFFFF
#endif
#define EN(j) ((PHMASK >> (j)) & 1)
#ifndef PROBE_DUP
#define PROBE_DUP 0x0
#endif
#define REPS(j) (1 + ((PROBE_DUP >> (j)) & 1))
#define IN(k) (lo <= (k) && (k) < hi)
#define SEAM(k) do { if (IN(k) && IN((k) + 1)) xcd_barrier(bar); } while (0)
    PG8_LAS unsigned char* ring = (PG8_LAS unsigned char*)(F.lds + RING_OFF);
    const int bx = blockIdx.x;

    if (EN(15) && IN(0)) for (int rep = 0; rep < REPS(15); ++rep) { phase_prologue(args, F); } SEAM(0);

    for (int l = 0; l < 2; ++l) {
        const int P = 1 + l * NPL;
        const bool lastl = (l == 1);
        bf16* HA = WSP(bf16, WS_HA); bf16* ACT = WSP(bf16, WS_Z); bf16* Zb = WSP(bf16, WS_Z); bf16* ABC = WSP(bf16, WS_ABC);
        float* xbuf = WSP(float, WS_XBUF);
        const float* PNONE = nullptr;
        bf16* HAc = HA + (size_t)ML * D; bf16* ACTc = ACT + (size_t)ML * FFN; bf16* ABCc = ABC + (size_t)ML * D;
        float* PART = WSP(float, WS_PART);
        if (EN(0) && IN(P + 0)) for (int rep = 0; rep < REPS(0); ++rep) { phase_norm<4>(args, F, l, 0, l == 0, MT, (l == 1 && rep == 0) ? modp(F, 0, 4, 8) : PNONE, 0.5f); } SEAM(P + 0);
        if (EN(1) && IN(P + 1)) for (int rep = 0; rep < REPS(1); ++rep) {
            { pg8::Gemm g{HA, wptr(F, l, WO_UP), D, D}; pg8::TwoPartOrder S; S.init(2 * FFN / 256, D, 2 * FFN / 256, 1, D, F.G, bx);
              pg8::EpiUp E{ACT, FFN, 0}; pg8::gemm_phase<pg8::EpiUp, pg8::TwoPartOrder>(ring, g, S, E); }
            if (l == 0 && rep == 0) conv_slot(args, F, 0, CS_UP1, bx - 176, 80);
            } SEAM(P + 1);
        if (EN(2) && IN(P + 2)) for (int rep = 0; rep < REPS(2); ++rep) {
            { pg8::Gemm g{ACT, wptr(F, l, WO_DN), FFN, FFN}; pg8::TwoPartOrder S; S.init(D / 256, FFN, D / 256, 4, FFN / 4, F.G, bx);
              pg8::EpiResidPart E{{l == 0 ? args.in[0] : xbuf, xbuf, modp(F, l, 0, 2), NMOD * D, rep + 1 == REPS(2) ? 0.5f : 0.f}, {PART}}; pg8::gemm_phase<pg8::EpiResidPart, pg8::TwoPartOrder>(ring, g, S, E); }
            if (l == 0 && rep == 0) conv_slot(args, F, CS_UP1, CS_DN1, bx - 128, 128);
            } SEAM(P + 2);
        if (EN(3) && IN(P + 3)) for (int rep = 0; rep < REPS(3); ++rep) { phase_norm<4>(args, F, l, 1, false, MT, rep == 0 ? modp(F, l, 4, 2) : PNONE, 0.5f); } SEAM(P + 3);
        if (EN(4) && IN(P + 4)) for (int rep = 0; rep < REPS(4); ++rep) {
            { pg8::Gemm g{HA, wptr(F, l, WO_IN), D, D}; pg8::TwoPartOrder S; S.init(INC / 256, D, (lastl ? 1280 : INC) / 256, 1, D, F.G, bx);
              pg8::EpiBf16 E{Zb, INC, 0, rep + 1 < REPS(4), COL_GATE / 256}; pg8::gemm_phase<pg8::EpiBf16, pg8::TwoPartOrder>(ring, g, S, E); }
            for (int rb = (bx + 192) % F.G; rb < MT / 64; rb += F.G) lr_block(args, F, l, rb);
            if (l == 0 && rep == 0) conv_slot(args, F, CS_UP1 + CS_DN1, CS_IN, bx - 160, 96);
        } SEAM(P + 4);
        if (EN(5) && IN(P + 5)) for (int rep = 0; rep < REPS(5); ++rep) { phase_prep(args, F, l); __syncthreads(); for (int u = bx; u < 4 * 4 * 68; u += F.G) gla1_unit(args, F, l, u); } SEAM(P + 5);
        if (EN(6) && IN(P + 6)) for (int rep = 0; rep < REPS(6); ++rep) { if (rep == 0) gla_scan(args, F);
            for (int u = bx; u < 512; u += F.G) attn_unit(args, F, l, u);
            __syncthreads();
            for (int u = (bx + 96) % F.G; u < 4 * ((lastl ? ML : MT) / 128); u += F.G) gmlp_unit(args, F, l, u); } SEAM(P + 6);
        if (EN(7) && IN(P + 7)) for (int rep = 0; rep < REPS(7); ++rep) { if (l == 0) { for (int u = 512 + bx; u < 544; u += F.G) attn_unit(args, F, l, u); __syncthreads(); }
            for (int u = (bx + 224) % F.G; u < 4 * 4 * (lastl ? 64 : 68); u += F.G) gla3_unit(args, F, l, lastl ? (u & 3) + 4 * ((u >> 2) % 64 + 68 * (u >> 8)) : u); } SEAM(P + 7);
        const int nMm = (lastl ? ML : MT) / 256;
        if (EN(8) && IN(P + 8)) for (int rep = 0; rep < REPS(8); ++rep) { pg8::Gemm g{ABC, wptr(F, l, WO_BRA), D, D}; pg8::MergeOrder S; S.init(nMm, D / 256, F.G, bx);
            pg8::EpiMergeR E{Zb + COL_GATE, INC, HA}; pg8::gemm_phase<pg8::EpiMergeR, pg8::MergeOrder>(ring, g, S, E);
            if (l == 0 && rep == 0) conv_slot(args, F, CS_UP1 + CS_DN1 + CS_IN, CS_MRG, bx - 32, 224);
            } SEAM(P + 8);
        if (EN(9) && IN(P + 9)) for (int rep = 0; rep < REPS(9); ++rep) {
            { pg8::Gemm g{HA, wptr(F, l, WO_OUT), D, D}; pg8::TwoPartOrder S; S.init(D / 256, D, lastl ? 0 : D / 256, 8, D / 8, F.G, bx);
              pg8::EpiResidPart E{{xbuf, xbuf, modp(F, l, 0, 5), NMOD * D, rep + 1 == REPS(9) ? 1.0f : 0.f}, {PART}}; pg8::gemm_phase<pg8::EpiResidPart, pg8::TwoPartOrder>(ring, g, S, E); } } SEAM(P + 9);
        if (EN(10) && IN(P + 10)) for (int rep = 0; rep < REPS(10); ++rep) { phase_norm<8>(args, F, l, 2, false, lastl ? ML : MT, (!lastl && rep == 0) ? modp(F, l, 4, 5) : PNONE, 1.0f); } SEAM(P + 10);
        if (EN(11) && IN(P + 11)) for (int rep = 0; rep < REPS(11); ++rep) {
            { pg8::Gemm g{HA, wptr(F, l, WO_UP + W_UP_E), D, D}; pg8::TwoPartOrder S; S.init(2 * FFN / 256, D, lastl ? 0 : 2 * FFN / 256, 1, D, F.G, bx);
              pg8::EpiUp E{ACT, FFN, 0}; pg8::gemm_phase<pg8::EpiUp, pg8::TwoPartOrder>(ring, g, S, E); }
            if (l == 0 && rep == 0) conv_slot(args, F, CS_UP1 + CS_DN1 + CS_IN + CS_MRG, CS_UP2, bx - 176, 80);
            } SEAM(P + 11);
        if (EN(12) && IN(P + 12)) for (int rep = 0; rep < REPS(12); ++rep) {
            { pg8::Gemm g{ACT, wptr(F, l, WO_DN + W_DN_E), FFN, FFN}; pg8::TwoPartOrder S; S.init(D / 256, FFN, lastl ? 0 : D / 256, 4, FFN / 4, F.G, bx);
              pg8::EpiResidPart E{{xbuf, (lastl && rep + 1 == REPS(12)) ? args.out : xbuf, modp(F, l, 0, 8), NMOD * D, rep + 1 == REPS(12) ? 0.5f : 0.f}, {PART}}; pg8::gemm_phase<pg8::EpiResidPart, pg8::TwoPartOrder>(ring, g, S, E); } }
        if (!lastl) SEAM(P + 12);
    }
#undef IN
#undef SEAM
}

extern "C" void kernel_launch(void* const* d_in, const int* in_sizes, int n_in, void* d_out, int out_size, void* d_ws, size_t ws_size, hipStream_t stream) {
    static int grid = 0;
    if (grid == 0) {
        if (n_in != 24 || out_size != ML * D || ws_size < WS_END) { fprintf(stderr, "kernel_launch: unexpected shapes (n_in %d out %d ws %zu need %zu)\n", n_in, out_size, ws_size, (size_t)WS_END); grid = -1; return; }
        int dev = 0, cus = 0, per_cu = 0;
        if (hipGetDevice(&dev) != hipSuccess || hipDeviceGetAttribute(&cus, hipDeviceAttributeMultiprocessorCount, dev) != hipSuccess) { grid = -1; return; }
        if (hipFuncSetAttribute((const void*)fwd_kernel, hipFuncAttributeMaxDynamicSharedMemorySize, LDS_BYTES) != hipSuccess) { fprintf(stderr, "kernel_launch: hipFuncSetAttribute failed\n"); grid = -1; return; }
        if (hipOccupancyMaxActiveBlocksPerMultiprocessor(&per_cu, (const void*)fwd_kernel, NWAVES * 64, LDS_BYTES) != hipSuccess || per_cu < 1)
            fprintf(stderr, "kernel_launch: occupancy query reports %d blocks per CU\n", per_cu);
        (void)hipGetLastError();
        grid = cus;
    }
    if (grid < 0) return;
    if (hipMemsetAsync((char*)d_ws + WS_CTL, 0, CTL_ZERO_BYTES, stream) != hipSuccess) return;
    Args a{};
    for (int i = 0; i < 24; ++i) a.in[i] = (const float*)d_in[i];
    a.out = (float*)d_out; a.ws = (unsigned char*)d_ws;
#if N_LAUNCH_MODE == 1
    a.ph_lo = 0; a.ph_hi = NPH;
    hipLaunchKernelGGL(fwd_kernel, dim3(grid), dim3(NWAVES * 64), LDS_BYTES, stream, a);
#else
    for (int p = 0; p < NPH; ++p) { a.ph_lo = p; a.ph_hi = p + 1; hipLaunchKernelGGL(fwd_kernel, dim3(grid), dim3(NWAVES * 64), LDS_BYTES, stream, a); }
#endif
}
```

```cpp
#include <hip/hip_runtime.h>
#include <cstdio>
#include <cstdint>

#ifndef N_LAUNCH_MODE
#define N_LAUNCH_MODE 1
#endif

#ifndef PROBE_SKIPEPI
#define PROBE_SKIPEPI 0
#endif
namespace pg8 {
#define PG8_LAS __attribute__((address_space(3)))
typedef unsigned short bf16_t;
typedef short bf16x8 __attribute__((ext_vector_type(8)));
typedef float f32x4 __attribute__((ext_vector_type(4)));
typedef unsigned u32x4 __attribute__((ext_vector_type(4)));
typedef unsigned u32x2 __attribute__((ext_vector_type(2)));
constexpr int BM = 256, BK = 64, HALF = 128, HTB = HALF * BK * 2, STAGE_BYTES = 8 * HTB, NXCD = 8, WGM = 8;

__host__ __device__ __forceinline__ int lds_byte(int r, int c) { const int st = (r >> 4) * 2 + (c >> 5), rr = r & 15, cc = c & 31, ob = rr * 64 + cc * 2; return st * 1024 + (ob ^ (((ob >> 9) & 1) << 5)); }
__host__ __device__ __forceinline__ void stage_rc(int b, int& R, int& C) { const int st = b / 1024, sb = b % 1024, swz = sb ^ (((sb >> 9) & 1) << 5); R = (st >> 1) * 16 + swz / 64; C = (st & 1) * 32 + (swz % 64) / 2; }
__host__ __device__ __forceinline__ int perm32(int rho) { const int n = rho >> 4, i = rho & 15; return 8 * (i >> 2) + 4 * n + (i & 3); }

struct Unit { int pm, pn, ks, nt; unsigned koff; };
struct Gemm { const bf16_t* A; const bf16_t* Bt; int lda, ldb; };

struct StaticOrder {
    int nM, nN, nwg, G, c, nt;
    __host__ __device__ void init(int nM_, int nN_, int G_, int c_, int K_) { nM = nM_; nN = nN_; nwg = nM * nN; G = G_; c = c_; nt = K_ / BK; }
    __host__ __device__ bool next(int i, Unit& u) const {
        const long L = (long)i * G + c; if (L >= nwg) return false;
        int wgid = (int)L; { const int q = nwg / NXCD, r = nwg % NXCD, xcd = wgid % NXCD, off = wgid / NXCD; wgid = (xcd < r ? xcd * (q + 1) : r * (q + 1) + (xcd - r) * q) + off; }
        const int nig = WGM * nN, gid = wgid / nig, fm = gid * WGM, gsz = (nM - fm) < WGM ? (nM - fm) : WGM;
        u.pm = fm + ((wgid % nig) % gsz); u.pn = (wgid % nig) / gsz; u.ks = 0; u.koff = 0u; u.nt = nt; return true;
    }
    __device__ __forceinline__ void a_ready(const Unit&) const {}
    __device__ __forceinline__ void done(const Unit&) const {}
};
struct SplitOrder {
    int nM, nN, nS, G, c, K;
    __host__ __device__ void init(int nM_, int nN_, int nS_, int G_, int c_, int K_) { nM = nM_; nN = nN_; nS = nS_; G = G_; c = c_; K = K_; }
    __host__ __device__ bool next(int i, Unit& u) const {
        const long L = (long)i * G + c; if (L >= (long)nM * nN * nS) return false;
        const int x = (int)L; u.ks = x % nS; u.pn = (x / nS) % nN; u.pm = x / (nS * nN); u.koff = (unsigned)(u.ks * K * 2); u.nt = K / BK; return true;
    }
    __device__ __forceinline__ void a_ready(const Unit&) const {}
    __device__ __forceinline__ void done(const Unit&) const {}
};

struct TwoPartOrder {
    StaticOrder L; int nL, nNc, ns, Kc;
    __host__ __device__ void init(int nNl, int Kl, int nNc_, int ns_, int Kc_, int G_, int c_) { L.init(64, nNl, G_, c_, Kl); nL = 64 * nNl; nNc = nNc_; ns = ns_; Kc = Kc_; }
    __host__ __device__ bool next(int i, Unit& u) const {
        const long Lx = (long)i * L.G + L.c;
        if (Lx < nL) return L.next(i, u);
        const int x = (int)(Lx - nL); if (x >= 4 * nNc * ns) return false;
        u.ks = x % ns; u.pn = (x / ns) % nNc; u.pm = 64 + x / (ns * nNc); u.koff = (unsigned)(u.ks * Kc * 2); u.nt = Kc / BK; return true;
    }
    __device__ __forceinline__ void a_ready(const Unit&) const {}
    __device__ __forceinline__ void done(const Unit&) const {}
};
struct MergeOrder {
    StaticOrder T;
    __host__ __device__ void init(int nM_, int nN_, int G_, int c_) { T.init(nM_, nN_, G_, c_, 0); }
    __host__ __device__ bool next(int i, Unit& u) const {
        const int it = i / 3, seg = i - 3 * it;
        if (!T.next(it, u)) return false;
        u.ks = seg; u.koff = seg == 0 ? 0u : (seg == 1 ? 1024u : 2048u); u.nt = seg == 2 ? 16 : 8; return true;
    }
    __device__ __forceinline__ void a_ready(const Unit&) const {}
    __device__ __forceinline__ void done(const Unit&) const {}
};
__device__ __forceinline__ unsigned cvt_pk_bf16(float lo, float hi) { unsigned r; asm volatile("v_cvt_pk_bf16_f32 %0, %1, %2" : "=v"(r) : "v"(lo), "v"(hi)); return r; }
__device__ __forceinline__ float bf_lo(unsigned w) { return __uint_as_float(w << 16); }
__device__ __forceinline__ float bf_hi(unsigned w) { return __uint_as_float(w & 0xffff0000u); }
__device__ __forceinline__ float fast_sigmoid(float x) { return __builtin_amdgcn_rcpf(1.0f + __expf(-x)); }

struct EpiBf16 {
    static constexpr bool PERM = true;
    bf16_t* O; int ldc; int pm_off; int skip; int gate_pn;
    __device__ __forceinline__ void operator()(const f32x4 (&acc)[2][2][4][2], const Unit& u, int wr, int wc, int fr, int fq) const {
        if (PROBE_SKIPEPI && skip) return;
        const int row0 = (u.pm + pm_off) * BM + wr * 64 + fr, col0 = u.pn * BM + wc * 32 + 8 * fq;
        const bool gate = u.pn >= gate_pn;
#pragma unroll
        for (int ai = 0; ai < 2; ++ai)
#pragma unroll
            for (int m = 0; m < 4; ++m) { bf16_t* rowp = O + (size_t)(row0 + ai * HALF + m * 16) * ldc + col0;
#pragma unroll
                for (int bj = 0; bj < 2; ++bj) { f32x4 v0 = acc[ai][bj][m][0], v1 = acc[ai][bj][m][1];
                    if (gate) {
#pragma unroll
                        for (int j = 0; j < 4; ++j) { v0[j] = 1.0f + __expf(-fminf(fmaxf(v0[j], -30.f), 30.f)); v1[j] = 1.0f + __expf(-fminf(fmaxf(v1[j], -30.f), 30.f)); } }
                    u32x4 w; w.x = cvt_pk_bf16(v0[0], v0[1]); w.y = cvt_pk_bf16(v0[2], v0[3]); w.z = cvt_pk_bf16(v1[0], v1[1]); w.w = cvt_pk_bf16(v1[2], v1[3]);
                    *(u32x4*)(rowp + bj * HALF) = w; } }
    }
};
struct EpiUp {
    static constexpr bool PERM = true;
    bf16_t* O; int ldc; int pm_off;
    __device__ __forceinline__ void operator()(const f32x4 (&acc)[2][2][4][2], const Unit& u, int wr, int wc, int fr, int fq) const {
        const int row0 = (u.pm + pm_off) * BM + wr * 64 + fr, col0 = u.pn * HALF + wc * 32 + 8 * fq;
#pragma unroll
        for (int ai = 0; ai < 2; ++ai)
#pragma unroll
            for (int m = 0; m < 4; ++m) { bf16_t* rowp = O + (size_t)(row0 + ai * HALF + m * 16) * ldc + col0;
                f32x4 r0, r1;
#pragma unroll
                for (int j = 0; j < 4; ++j) { const float g0 = acc[ai][0][m][0][j], g1 = acc[ai][0][m][1][j];
                    r0[j] = g0 * fast_sigmoid(g0) * acc[ai][1][m][0][j]; r1[j] = g1 * fast_sigmoid(g1) * acc[ai][1][m][1][j]; }
                u32x4 w; w.x = cvt_pk_bf16(r0[0], r0[1]); w.y = cvt_pk_bf16(r0[2], r0[3]); w.z = cvt_pk_bf16(r1[0], r1[1]); w.w = cvt_pk_bf16(r1[2], r1[3]);
                *(u32x4*)rowp = w; }
    }
};
struct EpiResid {
    static constexpr bool PERM = false;
    const float* xin; float* xout; const float* gate; int gate_stride; float scale;
    __device__ __forceinline__ void operator()(const f32x4 (&acc)[2][2][4][2], const Unit& u, int wr, int wc, int fr, int fq) const {
        if (PROBE_SKIPEPI && scale == 0.f) return;
        const int row0 = u.pm * BM + wr * 64 + fr, col0 = u.pn * BM + wc * 32 + 4 * fq;
        const int bidx = u.pm >> 4;
        f32x4 gv[2][2];
#pragma unroll
        for (int bj = 0; bj < 2; ++bj)
#pragma unroll
            for (int n = 0; n < 2; ++n) gv[bj][n] = *(const f32x4*)(gate + (size_t)bidx * gate_stride + col0 + bj * HALF + n * 16) * scale;
#pragma unroll
        for (int ai = 0; ai < 2; ++ai)
#pragma unroll
            for (int mh = 0; mh < 2; ++mh) { f32x4 xv[2][2][2];
#pragma unroll
                for (int mm = 0; mm < 2; ++mm) { const size_t off = (size_t)(row0 + ai * HALF + (2 * mh + mm) * 16) * 2048 + col0;
#pragma unroll
                    for (int bj = 0; bj < 2; ++bj)
#pragma unroll
                        for (int n = 0; n < 2; ++n) xv[mm][bj][n] = *(const f32x4*)(xin + off + bj * HALF + n * 16); }
#pragma unroll
                for (int mm = 0; mm < 2; ++mm) { const size_t off = (size_t)(row0 + ai * HALF + (2 * mh + mm) * 16) * 2048 + col0;
#pragma unroll
                    for (int bj = 0; bj < 2; ++bj)
#pragma unroll
                        for (int n = 0; n < 2; ++n) *(f32x4*)(xout + off + bj * HALF + n * 16) = xv[mm][bj][n] + gv[bj][n] * acc[ai][bj][2 * mh + mm][n]; } }
    }
};
struct EpiPart {
    static constexpr bool PERM = false;
    float* P;
    __device__ __forceinline__ void operator()(const f32x4 (&acc)[2][2][4][2], const Unit& u, int wr, int wc, int fr, int fq) const {
        const int row0 = u.pm * BM + wr * 64 + fr, col0 = u.pn * BM + wc * 32 + 4 * fq;
        float* base = P + (size_t)u.ks * 1024 * 2048;
#pragma unroll
        for (int ai = 0; ai < 2; ++ai)
#pragma unroll
            for (int m = 0; m < 4; ++m) { float* rowp = base + (size_t)(row0 + ai * HALF + m * 16) * 2048 + col0;
#pragma unroll
                for (int bj = 0; bj < 2; ++bj)
#pragma unroll
                    for (int n = 0; n < 2; ++n) *(f32x4*)(rowp + bj * HALF + n * 16) = acc[ai][bj][m][n]; }
    }
};
struct EpiMergeR {
    static constexpr bool PERM = true;
    const bf16_t* zg; int ldz; bf16_t* O;
    __device__ __forceinline__ bool keep(const Unit& u) const { return u.ks < 2; }
    __device__ __forceinline__ void operator()(f32x4 (&acc)[2][2][4][2], const Unit& u, int wr, int wc, int fr, int fq) const {
        const int row0 = u.pm * BM + wr * 64 + fr, col0 = u.pn * BM + wc * 32 + 8 * fq, seg = u.ks;
        const int cnum = (seg == 0 ? 1 : 2) * 2048, cden = (seg == 0 ? 0 : (seg == 1 ? 1 : 2)) * 2048;
#pragma unroll
        for (int ai = 0; ai < 2; ++ai)
#pragma unroll
            for (int mh = 0; mh < 2; ++mh) { u32x4 zn[2][2], zd[2][2];
#pragma unroll
                for (int mm = 0; mm < 2; ++mm) { const size_t row = (size_t)(row0 + ai * HALF + (2 * mh + mm) * 16);
#pragma unroll
                    for (int bj = 0; bj < 2; ++bj) { zd[mm][bj] = *(const u32x4*)(zg + row * ldz + cden + col0 + bj * HALF);
                        zn[mm][bj] = seg < 2 ? *(const u32x4*)(zg + row * ldz + cnum + col0 + bj * HALF) : (u32x4){0u, 0u, 0u, 0u}; } }
#pragma unroll
                for (int mm = 0; mm < 2; ++mm) { const size_t row = (size_t)(row0 + ai * HALF + (2 * mh + mm) * 16); const int m = 2 * mh + mm;
#pragma unroll
                    for (int bj = 0; bj < 2; ++bj) { const u32x4 d4 = zd[mm][bj], n4 = zn[mm][bj];
                        const float dz[8] = {bf_lo(d4.x), bf_hi(d4.x), bf_lo(d4.y), bf_hi(d4.y), bf_lo(d4.z), bf_hi(d4.z), bf_lo(d4.w), bf_hi(d4.w)};
                        const float nz[8] = {bf_lo(n4.x), bf_hi(n4.x), bf_lo(n4.y), bf_hi(n4.y), bf_lo(n4.z), bf_hi(n4.z), bf_lo(n4.w), bf_hi(n4.w)};
                        float r[8];
#pragma unroll
                        for (int e = 0; e < 8; ++e) { const float num = seg < 2 ? nz[e] : 1.0f; r[e] = num * __builtin_amdgcn_rcpf(dz[e]); }
                        f32x4 v0 = acc[ai][bj][m][0], v1 = acc[ai][bj][m][1];
                        v0[0] *= r[0]; v0[1] *= r[1]; v0[2] *= r[2]; v0[3] *= r[3]; v1[0] *= r[4]; v1[1] *= r[5]; v1[2] *= r[6]; v1[3] *= r[7];
                        if (seg < 2) { acc[ai][bj][m][0] = v0; acc[ai][bj][m][1] = v1; }
                        else { u32x4 w; w.x = cvt_pk_bf16(v0[0], v0[1]); w.y = cvt_pk_bf16(v0[2], v0[3]); w.z = cvt_pk_bf16(v1[0], v1[1]); w.w = cvt_pk_bf16(v1[2], v1[3]);
                            *(u32x4*)(O + row * 2048 + col0 + bj * HALF) = w; } } } }
    }
};
struct EpiResidPart {
    static constexpr bool PERM = false;
    EpiResid R; EpiPart P;
    __device__ __forceinline__ void operator()(const f32x4 (&acc)[2][2][4][2], const Unit& u, int wr, int wc, int fr, int fq) const {
        if (u.pm < 64) R(acc, u, wr, wc, fr, fq); else { Unit v = u; v.pm = u.pm - 64; P(acc, v, wr, wc, fr, fq); }
    }
};
template <class E> __device__ __forceinline__ auto epi_keep(const E& e, const Unit& u, int) -> decltype(e.keep(u)) { return e.keep(u); }
template <class E> __device__ __forceinline__ bool epi_keep(const E&, const Unit&, long) { return false; }
template <class Epi, class Sched, bool ALIGN_EPI = true>
__device__ __forceinline__ void gemm_phase(PG8_LAS unsigned char* lds, const Gemm g, const Sched& S, const Epi& E) {
    int tid_ = threadIdx.x; asm volatile("" : "+v"(tid_));
    const int tid = tid_, wid = __builtin_amdgcn_readfirstlane(tid >> 6), lane = tid & 63, wr = wid >> 2, wc = wid & 3, fr = lane & 15, fq = lane >> 4;
    unsigned voffA[2], voffB[2];
#pragma unroll
    for (int i = 0; i < 2; ++i) { int R, C; stage_rc(tid * 16 + i * 8192, R, C); const int Rb = Epi::PERM ? ((R & ~31) + perm32(R & 31)) : R;
        voffA[i] = (unsigned)(R * g.lda + C) * 2u; voffB[i] = (unsigned)(Rb * g.ldb + C) * 2u; }
    const size_t kstep = (size_t)(BK * 2);
    const size_t hA = (size_t)HALF * g.lda * 2, hB = (size_t)HALF * g.ldb * 2;
    const size_t tA = 2 * hA, tB = 2 * hB;
    const unsigned ldsw = (unsigned)wid * 1024u;
    const int aoff = lds_byte(wr * 64 + fr, fq * 8), boff = lds_byte(wc * 32 + fr, fq * 8);
#define PG8_SA(b, h) (((b) * 2 + (h)) * HTB)
#define PG8_SB(b, h) ((4 + (b) * 2 + (h)) * HTB)
#define PG8_STAGE(bufoff, gbase, voff) do { _Pragma("unroll") for (int _i = 0; _i < 2; ++_i) \
        __builtin_amdgcn_global_load_lds((const unsigned*)((const char*)(gbase) + (voff)[_i]), (PG8_LAS unsigned*)(lds + (bufoff) + ldsw + _i * 8192), 16, 0, 0); } while (0)
#define PG8_LDA(dst, b, h) do { _Pragma("unroll") for (int m = 0; m < 4; ++m) _Pragma("unroll") for (int k = 0; k < 2; ++k) dst[m][k] = *(const PG8_LAS bf16x8*)(lds + PG8_SA(b, h) + aoff + m * 2048 + k * 1024); } while (0)
#define PG8_LDB(dst, b, h) do { _Pragma("unroll") for (int n = 0; n < 2; ++n) _Pragma("unroll") for (int k = 0; k < 2; ++k) dst[n][k] = *(const PG8_LAS bf16x8*)(lds + PG8_SB(b, h) + boff + n * 2048 + k * 1024); } while (0)
#define PG8_MMA(ai, bj, At, Bt) do { __builtin_amdgcn_s_setprio(1); _Pragma("unroll") for (int m = 0; m < 4; ++m) _Pragma("unroll") for (int n = 0; n < 2; ++n) _Pragma("unroll") for (int k = 0; k < 2; ++k) \
        acc[ai][bj][m][n] = __builtin_amdgcn_mfma_f32_16x16x32_bf16(Bt[n][k], At[m][k], acc[ai][bj][m][n], 0, 0, 0); __builtin_amdgcn_s_setprio(0); } while (0)
#define PG8_WAIT_V(n) asm volatile("s_waitcnt vmcnt(" #n ")" ::: "memory")
#define PG8_WAIT_L(n) asm volatile("s_waitcnt lgkmcnt(" #n ")" ::: "memory")
#define PG8_BAR __builtin_amdgcn_s_barrier()
#define PG8_SCHED __builtin_amdgcn_sched_barrier(0)
    Unit cur, nxt; int ui = 0;
    if (!S.next(0, cur)) return;
    f32x4 acc[2][2][4][2];
#pragma unroll
    for (int a = 0; a < 2; ++a)
#pragma unroll
        for (int b = 0; b < 2; ++b)
#pragma unroll
            for (int m = 0; m < 4; ++m)
#pragma unroll
                for (int n = 0; n < 2; ++n) acc[a][b][m][n] = (f32x4){0.f, 0.f, 0.f, 0.f};
    bf16x8 At[4][2], B0[2][2], B1[2][2];
    const char* cA = (const char*)g.A + (size_t)cur.pm * tA + cur.koff; const char* cB = (const char*)g.Bt + (size_t)cur.pn * tB + cur.koff;
    S.a_ready(cur);
    PG8_STAGE(PG8_SB(0, 0), cB, voffB); PG8_STAGE(PG8_SB(0, 1), cB + hB, voffB); PG8_STAGE(PG8_SA(0, 0), cA, voffA); PG8_STAGE(PG8_SA(0, 1), cA + hA, voffA);
    if (wr == 1) PG8_BAR;
    PG8_WAIT_V(2); PG8_BAR;
    PG8_STAGE(PG8_SB(1, 0), cB + kstep, voffB); PG8_STAGE(PG8_SA(1, 0), cA + kstep, voffA); PG8_STAGE(PG8_SB(1, 1), cB + hB + kstep, voffB);
    PG8_WAIT_V(6); PG8_BAR;
    for (;;) {
        const bool has_next = S.next(ui + 1, nxt);
        const char* nA = has_next ? (const char*)g.A + (size_t)nxt.pm * tA + nxt.koff : cA; const char* nB = has_next ? (const char*)g.Bt + (size_t)nxt.pn * tB + nxt.koff : cB;
        const int nt = cur.nt;
        for (int t = 0; t < nt; t += 2) {
            const bool last = (t == nt - 2);
            const char* a1 = cA + (size_t)(t + 1) * kstep;
            const char* a2 = last ? nA : cA + (size_t)(t + 2) * kstep; const char* b2 = last ? nB : cB + (size_t)(t + 2) * kstep;
            const char* a3 = a2 + kstep; const char* b3 = b2 + kstep;
            if (last && has_next) S.a_ready(nxt);
            PG8_LDB(B0, 0, 0); PG8_LDB(B1, 0, 1); PG8_SCHED; PG8_LDA(At, 0, 0); PG8_STAGE(PG8_SA(1, 1), a1 + hA, voffA);
            PG8_WAIT_V(8); PG8_WAIT_L(0); PG8_BAR; PG8_MMA(0, 0, At, B0); PG8_MMA(0, 1, At, B1); PG8_BAR; PG8_SCHED;
            PG8_LDA(At, 0, 1); PG8_STAGE(PG8_SB(0, 0), b2, voffB); PG8_STAGE(PG8_SB(0, 1), b2 + hB, voffB); PG8_STAGE(PG8_SA(0, 0), a2, voffA);
            PG8_WAIT_V(8); PG8_WAIT_L(0); PG8_BAR; PG8_MMA(1, 0, At, B0); PG8_MMA(1, 1, At, B1); PG8_BAR; PG8_SCHED;
            PG8_LDB(B0, 1, 0); PG8_LDB(B1, 1, 1); PG8_SCHED; PG8_LDA(At, 1, 0); PG8_STAGE(PG8_SA(0, 1), a2 + hA, voffA);
            PG8_WAIT_V(8); PG8_WAIT_L(0); PG8_BAR; PG8_MMA(0, 0, At, B0); PG8_MMA(0, 1, At, B1); PG8_BAR; PG8_SCHED;
            PG8_LDA(At, 1, 1); PG8_STAGE(PG8_SB(1, 0), b3, voffB); PG8_STAGE(PG8_SB(1, 1), b3 + hB, voffB); PG8_STAGE(PG8_SA(1, 0), a3, voffA);
            PG8_WAIT_V(8); PG8_WAIT_L(0); PG8_BAR; PG8_MMA(1, 0, At, B0); PG8_MMA(1, 1, At, B1); PG8_BAR; PG8_SCHED;
        }
        if constexpr (ALIGN_EPI) { if (wr == 0) PG8_BAR; }
        E(acc, cur, wr, wc, fr, fq); S.done(cur);
        if (!has_next) break;
        if (!epi_keep(E, cur, 0)) {
#pragma unroll
        for (int a = 0; a < 2; ++a)
#pragma unroll
            for (int b = 0; b < 2; ++b)
#pragma unroll
                for (int m = 0; m < 4; ++m)
#pragma unroll
                    for (int n = 0; n < 2; ++n) acc[a][b][m][n] = (f32x4){0.f, 0.f, 0.f, 0.f};
        }
        cur = nxt; cA = nA; cB = nB; ++ui;
        if constexpr (ALIGN_EPI) { if (wr == 1) PG8_BAR; }
    }
    PG8_WAIT_V(0);
    if constexpr (!ALIGN_EPI) { if (wr == 0) PG8_BAR; }
    PG8_BAR;
#undef PG8_SA
#undef PG8_SB
#undef PG8_STAGE
#undef PG8_LDA
#undef PG8_LDB
#undef PG8_MMA
#undef PG8_WAIT_V
#undef PG8_WAIT_L
#undef PG8_BAR
#undef PG8_SCHED
}
}

constexpr int NWAVES = 8;
constexpr int D = 2048, BATCH = 4, SEQ = 4096, CTXL = 256, FFN = 5632, INC = 10240, NMOD = 9;
constexpr int ML = BATCH * SEQ, MC = BATCH * CTXL, MT = ML + MC;
constexpr int COL_BK = 0, COL_BV = 256, COL_CK = 768, COL_CV = 1024, COL_AU = 1280, COL_AV = 1792, COL_BQ = 2304, COL_BG = 2560, COL_CQ = 3072, COL_GATE = 4096;
constexpr float EPS = 1e-6f;

constexpr size_t MiB = 1u << 20;
constexpr size_t al(size_t x) { return (x + 4095) & ~(size_t)4095; }
constexpr size_t WS_CTL = 0, CTL_ZERO_BYTES = 1 * MiB;
constexpr size_t WS_MOD = 1 * MiB;
constexpr size_t WS_W = 2 * MiB;
constexpr size_t W_UP_E = (size_t)2 * FFN * D, W_DN_E = (size_t)D * FFN, W_IN_E = (size_t)INC * D, W_BRA_E = (size_t)D * 512, W_BRC_E = (size_t)D * 1024, W_OUT_E = (size_t)D * D, W_LR_E = (size_t)256 * D;
constexpr size_t WO_UP = 0, WO_DN = WO_UP + 2 * W_UP_E, WO_IN = WO_DN + 2 * W_DN_E, WO_BRA = WO_IN + W_IN_E, WO_BRB = WO_BRA + W_BRA_E, WO_BRC = WO_BRB + W_BRA_E, WO_OUT = WO_BRC + W_BRC_E, WO_LR = WO_OUT + W_OUT_E,
                 W_LAYER_E = WO_LR + W_LR_E;
constexpr size_t WS_XBUF = al(WS_W + 2 * W_LAYER_E * 2);
constexpr size_t WS_HA = al(WS_XBUF + (size_t)MT * D * 4);
constexpr size_t WS_ABC = al(WS_HA + (size_t)MT * D * 2);
constexpr size_t WS_Z = al(WS_ABC + (size_t)MT * D * 2);
constexpr size_t WS_MIX = al(WS_Z + (size_t)MT * INC * 2);
constexpr size_t WS_QN = WS_MIX;
constexpr size_t WS_KN = al(WS_QN + (size_t)MT * 1024 * 2);
constexpr size_t WS_VN = al(WS_KN + (size_t)MT * 256 * 2);
constexpr size_t WS_LR = al(WS_VN + (size_t)MT * 512 * 2);
constexpr size_t WS_ST = al(WS_LR + (size_t)MT * 32 * 4);
constexpr size_t WS_DEC = al(WS_ST + (size_t)32 * 68 * 8192 * 4);
constexpr size_t WS_MIX_USED = al(WS_DEC + (size_t)32 * 68 * 64 * 4);
constexpr size_t WS_MIX_END = (WS_MIX_USED > WS_MIX + (size_t)MT * D * 4) ? WS_MIX_USED : al(WS_MIX + (size_t)MT * D * 4);
constexpr size_t WS_MERGEF = WS_MIX;
static_assert(WS_MERGEF + (size_t)MT * D * 4 <= WS_MIX_END, "MERGEF overlay");
constexpr size_t WS_PART = WS_MIX_END;
constexpr size_t WS_END = WS_PART + (size_t)8 * MC * D * 4;
static_assert(WS_END <= (size_t)1476395008, "workspace map exceeds the guaranteed d_ws size");
constexpr int CW_BAR = 4096;

constexpr int RING_OFF = 0, RING_BYTES = 131072;
constexpr int LDS_BYTES = 147456;
constexpr int LDSCTL_OFF = LDS_BYTES - 512, MISC_OFF = LDSCTL_OFF + 320;

#define GAS __attribute__((address_space(1)))
#define LAS __attribute__((address_space(3)))
typedef unsigned short bf16;
typedef unsigned v4u __attribute__((ext_vector_type(4)));
typedef unsigned v2u __attribute__((ext_vector_type(2)));
typedef float f32x4 __attribute__((ext_vector_type(4)));
typedef short bf16x8 __attribute__((ext_vector_type(8)));
typedef short s16x4 __attribute__((ext_vector_type(4)));
#define MFMA16(a, b, c) __builtin_amdgcn_mfma_f32_16x16x32_bf16((a), (b), (c), 0, 0, 0)
#define LDS_WAIT() asm volatile("s_waitcnt lgkmcnt(0)" ::: "memory")
#define VM_WAIT() asm volatile("s_waitcnt vmcnt(0)" ::: "memory")
__device__ __forceinline__ unsigned f2bf(float f) { unsigned u = __builtin_bit_cast(unsigned, f); return (u + 0x7fffu + ((u >> 16) & 1u)) >> 16; }
__device__ __forceinline__ unsigned pk2(float lo, float hi) { return f2bf(lo) | (f2bf(hi) << 16); }
__device__ __forceinline__ float bf2f(bf16 b) { return __uint_as_float(((unsigned)b) << 16); }
__device__ __forceinline__ float blo(unsigned w) { return __uint_as_float(w << 16); }
__device__ __forceinline__ float bhi(unsigned w) { return __uint_as_float(w & 0xffff0000u); }
__device__ __forceinline__ float wave_sum(float v) {
#pragma unroll
    for (int o = 1; o < 64; o <<= 1) v += __shfl_xor(v, o);
    return v;
}
__device__ __forceinline__ float wave_max(float v) {
#pragma unroll
    for (int o = 1; o < 64; o <<= 1) v = fmaxf(v, __shfl_xor(v, o));
    return v;
}
__device__ __forceinline__ float silu_f(float x) { return x / (1.0f + __expf(-x)); }
__device__ __forceinline__ float gelu_tanh(float x) { const float u = 1.5957691216057308f * (x + 0.044715f * x * x * x); return x * __builtin_amdgcn_rcpf(1.0f + __expf(-u)); }
__device__ __forceinline__ float log_sigmoid(float x) { return fminf(x, 0.f) - __logf(1.0f + __expf(-fabsf(x))); }

#define XB_TMO      128
#define XB_XCNT(j)  (256  + 64 * (j))
#define XB_XSUB(j)  (1280 + 64 * (j))
#define XB_XGEN(j)  (2304 + 64 * (j))
#define XB_TOP      3328
#define XB_TOPGEN   3392
#define XCD_BAR_WORDS 3456
#define XB_SPIN_CAP (1u << 18)
__device__ __forceinline__ unsigned xb_ld(unsigned* p)              { return __hip_atomic_load(p, __ATOMIC_RELAXED, __HIP_MEMORY_SCOPE_AGENT); }
__device__ __forceinline__ unsigned xb_add(unsigned* p, unsigned v) { return __hip_atomic_fetch_add(p, v, __ATOMIC_RELAXED, __HIP_MEMORY_SCOPE_AGENT); }
__device__ __forceinline__ unsigned xb_xcc_id() { return (unsigned)__builtin_amdgcn_s_getreg((3 << 11) | 20) & 0xFu; }
#define XB_SPIN(cond, bar) do { unsigned _sp = 0; while (cond) { __builtin_amdgcn_s_sleep(1); \
    if ((++_sp & 255u) == 0u) { if (xb_ld(&(bar)[XB_TMO])) break; if (_sp > XB_SPIN_CAP) { atomicAdd(&(bar)[XB_TMO], 1u); break; } } } } while (0)
struct XcdBarrier { unsigned* bar; unsigned x; volatile LAS unsigned* st; };
__device__ __forceinline__ XcdBarrier xcd_barrier_post(unsigned* bar, volatile LAS unsigned* st) {
    XcdBarrier b; b.bar = bar; b.x = xb_xcc_id(); b.st = st;
    if (threadIdx.x == 0) (void)xb_add(&bar[XB_XCNT(b.x)], 1u);
    return b;
}
__device__ __forceinline__ void xcd_barrier_complete(unsigned* bar, unsigned x, unsigned& nloc, unsigned& nx) {
    const unsigned G = gridDim.x * gridDim.y * gridDim.z;
    unsigned sum, cnt, mine, sp = 0u;
    for (;;) {
        sum = 0u; cnt = 0u; mine = 0u;
#pragma unroll
        for (unsigned j = 0; j < 16; ++j) { const unsigned c = xb_ld(&bar[XB_XCNT(j)]); sum += c; cnt += (c > 0u) ? 1u : 0u; mine = (j == x) ? c : mine; }
        if (sum == G) break;
        __builtin_amdgcn_s_sleep(1);
        if ((++sp & 255u) == 0u) { if (xb_ld(&bar[XB_TMO])) break; if (sp > XB_SPIN_CAP) { atomicAdd(&bar[XB_TMO], 1u); break; } }
    }
    nloc = mine > 0u ? mine : 1u; nx = cnt > 0u ? cnt : 1u;
}
__device__ __forceinline__ void xcd_barrier(const XcdBarrier& b) {
    asm volatile("s_waitcnt vmcnt(0)" ::: "memory");
    __syncthreads();
    if (threadIdx.x == 0) {
        unsigned* bar = b.bar;
        __builtin_amdgcn_s_waitcnt(0);
        unsigned nloc = b.st[0], nx = b.st[1];
        if (nloc == 0u) { xcd_barrier_complete(bar, b.x, nloc, nx); b.st[0] = nloc; b.st[1] = nx; }
        const unsigned old = xb_add(&bar[XB_XSUB(b.x)], 1u);
        const unsigned gen = old / nloc;
        if (old + 1u == (gen + 1u) * nloc) {
            __builtin_amdgcn_fence(__ATOMIC_RELEASE, "agent");
            asm volatile("s_waitcnt vmcnt(0)" ::: "memory");
            const unsigned og = xb_add(&bar[XB_TOP], 1u);
            const unsigned tg = og / nx;
            if (og + 1u == (tg + 1u) * nx) xb_add(&bar[XB_TOPGEN], 1u);
            else XB_SPIN(xb_ld(&bar[XB_TOPGEN]) == tg, bar);
            __builtin_amdgcn_fence(__ATOMIC_ACQUIRE, "agent");
            xb_add(&bar[XB_XGEN(b.x)], 1u);
            asm volatile("s_waitcnt vmcnt(0)" ::: "memory");
        } else {
            XB_SPIN(xb_ld(&bar[XB_XGEN(b.x)]) == gen, bar);
            __builtin_amdgcn_fence(__ATOMIC_ACQUIRE, "agent");
            asm volatile("s_waitcnt vmcnt(0)" ::: "memory");
        }
    }
    __syncthreads();
}

struct Frame {
    LAS unsigned char* lds;
    int tid, lane, wave, G, gw, ngw;
    unsigned char* ws;
};
struct Args { const float* in[24]; float* out; unsigned char* ws; int ph_lo, ph_hi; };
#define WSP(T, off) ((T*)(F.ws + (off)))
__device__ __forceinline__ bf16* wptr(const Frame& F, int l, size_t off) { return (bf16*)(F.ws + WS_W) + (size_t)l * W_LAYER_E + off; }
__device__ __forceinline__ const float* modp(const Frame& F, int l, int bidx, int k) { return (const float*)(F.ws + WS_MOD) + ((size_t)(l * 5 + bidx) * NMOD + k) * D; }

__device__ __forceinline__ int opqv(int v) { asm volatile("" : "+v"(v)); return v; }
__device__ __forceinline__ int opqs(int v) { asm volatile("" : "+s"(v)); return v; }
#define PH_IDS const int tid = opqv(F.tid), lane = tid & 63, wave = opqs(F.wave), gw = blockIdx.x * NWAVES + wave, ngw = F.G * NWAVES; (void)tid; (void)lane; (void)wave; (void)gw; (void)ngw
__device__ __forceinline__ void transpose_item(const float* W, int N, int ldk, bf16* WT, int k0, int nsrc0, int ndst0, LAS float* scr, int lane) {
    float tv[32];
#pragma unroll
    for (int i = 0; i < 32; ++i) { const int kk = 2 * i + (lane >> 5); tv[i] = W[(size_t)(k0 + kk) * N + nsrc0 + (lane & 31)]; }
#pragma unroll
    for (int i = 0; i < 32; ++i) { const int kk = 2 * i + (lane >> 5); scr[kk * 33 + (lane & 31)] = tv[i]; }
    LDS_WAIT(); asm volatile("" ::: "memory");
    const int c = lane & 7;
#pragma unroll
    for (int j = 0; j < 4; ++j) { const int n = (lane >> 3) + 8 * j; const LAS float* s = scr + (8 * c) * 33 + n;
        v4u o; o.x = pk2(s[0 * 33], s[1 * 33]); o.y = pk2(s[2 * 33], s[3 * 33]); o.z = pk2(s[4 * 33], s[5 * 33]); o.w = pk2(s[6 * 33], s[7 * 33]);
        *(v4u*)(WT + (size_t)(ndst0 + n) * ldk + k0 + 8 * c) = o; }
    LDS_WAIT(); asm volatile("" ::: "memory");
}
constexpr int I_UP = 32 * 352, I_DN = 88 * 64, I_IN = 32 * 320, I_BA = 8 * 64, I_BC = 16 * 64, I_OUT = 32 * 64;
constexpr int I_LAYER = 2 * I_UP + 2 * I_DN + I_IN + 2 * I_BA + I_BC + I_OUT;
__device__ __forceinline__ void conv_item(const Args& args, Frame& F, int l, int r, LAS float* scr, int lane) {
    const float* src; bf16* dst; int N, K; bool up = false; int ldk = 0;
    if (r < 2 * I_UP) { const int f = r / I_UP; r %= I_UP; src = args.in[7] + (size_t)(l * 2 + f) * D * 2 * FFN; dst = wptr(F, l, WO_UP + f * W_UP_E); N = 2 * FFN; K = D; up = true; }
    else if ((r -= 2 * I_UP) < 2 * I_DN) { const int f = r / I_DN; r %= I_DN; src = args.in[8] + (size_t)(l * 2 + f) * FFN * D; dst = wptr(F, l, WO_DN + f * W_DN_E); N = D; K = FFN; }
    else if ((r -= 2 * I_DN) < I_IN) { src = args.in[9] + (size_t)l * D * INC; dst = wptr(F, l, WO_IN); N = INC; K = D; }
    else if ((r -= I_IN) < I_BA) { src = args.in[20] + (size_t)l * 512 * D; dst = wptr(F, l, WO_BRA); N = D; K = 512; ldk = D; }
    else if ((r -= I_BA) < I_BA) { src = args.in[21] + (size_t)l * 512 * D; dst = wptr(F, l, WO_BRA) + 512; N = D; K = 512; ldk = D; }
    else if ((r -= I_BA) < I_BC) { src = args.in[22] + (size_t)l * 1024 * D; dst = wptr(F, l, WO_BRA) + 1024; N = D; K = 1024; ldk = D; }
    else { r -= I_BC; src = args.in[23] + (size_t)l * D * D; dst = wptr(F, l, WO_OUT); N = D; K = D; }
    const int nblk = N / 32, kb = r / nblk, nb = r % nblk, ndst0 = 32 * nb;
    int nsrc0 = ndst0;
    if (up) { const int pn = ndst0 >> 8, w = ndst0 & 255; nsrc0 = (w >> 7) * FFN + 128 * pn + (w & 127); }
    transpose_item(src, N, ldk ? ldk : K, dst, 64 * kb, nsrc0, ndst0, scr, lane);
}
constexpr int I_BR = 2 * I_BA + I_BC;
constexpr int CQ_L0 = I_LAYER - I_UP, CQ_ALL = CQ_L0 + I_LAYER;
__device__ __forceinline__ void conv_q(const Args& args, Frame& F, int q, LAS float* scr, int lane) {
    int l = 0;
    if (q >= CQ_L0) { l = 1; q -= CQ_L0; if (q < I_UP) { conv_item(args, F, 1, q, scr, lane); return; } q -= I_UP; }
    int r;
    if (q < I_DN) r = 2 * I_UP + q;
    else if ((q -= I_DN) < I_IN + I_BR + I_OUT) r = 2 * I_UP + 2 * I_DN + q;
    else if ((q -= I_IN + I_BR + I_OUT) < I_UP) r = I_UP + q;
    else r = 2 * I_UP + I_DN + (q - I_UP);
    conv_item(args, F, l, r, scr, lane);
}
__device__ __forceinline__ void conv_slot(const Args& args, Frame& F, int q0, int cnt, int j, int nj) {
    PH_IDS;
    if (j < 0 || j >= nj) return;
    const int q1 = (q0 + cnt) < CQ_ALL ? (q0 + cnt) : CQ_ALL;
    LAS float* scr = (LAS float*)(F.lds + wave * 16384);
    for (int q = q0 + j * NWAVES + wave; q < q1; q += nj * NWAVES) conv_q(args, F, q, scr, lane);
    __syncthreads();
}
constexpr int CQ_PRE = 2048;
constexpr int CQ_N[2][6] = {{6400, 7680, 7680, 19712, 6400, 7680}, {6400, 7680, 20000, 0, 0, 0}};
constexpr int cq_start(int l, int k) { int s = CQ_PRE; for (int a = 0; a < 2; ++a) for (int b = 0; b < 6; ++b) { if (a == l && b == k) return s; s += CQ_N[a][b]; } return s; }
static_assert(cq_start(0, 1) >= I_DN, "down[0] of layer 0 ready before its down phase");
static_assert(cq_start(0, 2) >= I_DN + I_IN, "in of layer 0");
static_assert(cq_start(0, 3) >= I_DN + I_IN + I_BR, "branch lifts of layer 0");
static_assert(cq_start(0, 4) >= I_DN + I_IN + I_BR + I_OUT + I_UP, "out and up[1] of layer 0 (both before the up2 slot)");
static_assert(cq_start(0, 5) >= CQ_L0, "down[1] of layer 0");
static_assert(cq_start(1, 0) >= CQ_L0 + I_UP, "up[0] of layer 1");
static_assert(cq_start(1, 1) >= CQ_L0 + I_UP + I_DN, "down[0] of layer 1");
static_assert(cq_start(1, 2) >= CQ_L0 + I_UP + I_DN + I_IN, "in of layer 1");
static_assert(cq_start(1, 3) >= CQ_ALL, "everything converted before layer 1's merge");
__device__ __forceinline__ void phase_prologue(const Args& args, Frame& F) {
    PH_IDS;
    LAS float* scr = (LAS float*)(F.lds + wave * 16384);
    for (int it = gw; it < I_UP + CQ_PRE; it += ngw) { if (it < I_UP) conv_item(args, F, 0, it, scr, lane); else conv_q(args, F, it - I_UP, scr, lane); }
    for (int l = 0; l < 2; ++l) {
        bf16* dst = wptr(F, l, WO_LR); const float* w1 = args.in[13] + (size_t)l * 2 * D * 16;
        for (int i = blockIdx.x * 512 + tid; i < 32 * D; i += F.G * 512) { const int n = i / D, k = i % D;
            dst[i] = (bf16)f2bf(w1[((size_t)(n >> 4) * D + k) * 16 + (n & 15)]); }
    }
    __syncthreads();
    LAS float* cact = (LAS float*)F.lds;
    LAS float* red = (LAS float*)(F.lds + 40960);
    for (int i = tid; i < 5 * D; i += 512) { const int b = i / D, k = i % D; const float v = b < 4 ? args.in[1][b * D + k] : args.in[3][k]; cact[i] = silu_f(v); }
    __syncthreads();
    for (int u = blockIdx.x; u < 256; u += F.G) {
        const int l = u >> 7, cb = (u & 127) * 144;
        if (tid < 504) {
            const int cg = tid % 36, ks = tid / 36, k0 = ks * 147, k1 = (k0 + 147) < D ? (k0 + 147) : D;
            f32x4 a0 = {0, 0, 0, 0}, a1 = a0, a2 = a0, a3 = a0, a4 = a0;
            const float* wp = args.in[4] + (size_t)l * D * (NMOD * D) + cb + cg * 4;
#pragma unroll 12
            for (int k = k0; k < k1; ++k) { const f32x4 w = *(const f32x4*)(wp + (size_t)k * (NMOD * D));
                a0 += cact[k] * w; a1 += cact[D + k] * w; a2 += cact[2 * D + k] * w; a3 += cact[3 * D + k] * w; a4 += cact[4 * D + k] * w; }
            LAS float* rp = red + ks * 720 + cg * 4;
#pragma unroll
            for (int j = 0; j < 4; ++j) { rp[j] = a0[j]; rp[144 + j] = a1[j]; rp[288 + j] = a2[j]; rp[432 + j] = a3[j]; rp[576 + j] = a4[j]; }
        }
        __syncthreads();
        for (int idx = tid; idx < 720; idx += 512) { const int i = idx / 144, cc = idx % 144; float s = 0.f;
#pragma unroll
            for (int ks = 0; ks < 14; ++ks) s += red[ks * 720 + idx];
            s += args.in[5][(size_t)l * NMOD * D + cb + cc];
            ((float*)(F.ws + WS_MOD))[(size_t)(l * 5 + i) * NMOD * D + cb + cc] = s; }
        __syncthreads();
    }
}

template <int NS> __device__ __forceinline__ void phase_norm(const Args& args, Frame& F, int l, int which, bool first, int nrows, const float* pgate, float pscale) {
    PH_IDS;
    float* xbuf = WSP(float, WS_XBUF); bf16* HA = WSP(bf16, WS_HA);
    const float* gain = args.in[6] + (size_t)(l * 3 + which) * D;
    for (int row = gw; row < nrows; row += ngw) {
        const float* src = first ? (row < ML ? args.in[0] + (size_t)row * D : args.in[2] + (size_t)(row - ML) * D) : xbuf + (size_t)row * D;
        const int bidx = row < ML ? (row >> 12) : 4;
        const float* sh = modp(F, l, bidx, 3 * which), * sc = modp(F, l, bidx, 3 * which + 1);
        f32x4 v[8]; float ss = 0.f;
#pragma unroll
        for (int j = 0; j < 8; ++j) v[j] = ((const f32x4*)src)[lane + 64 * j];
        const bool upd = (pgate != nullptr) && row >= ML;
        if (upd) { const float* pp = WSP(float, WS_PART) + (size_t)(row - ML) * D;
#pragma unroll
            for (int j = 0; j < 8; ++j) { f32x4 pa[NS];
#pragma unroll
                for (int ks = 0; ks < NS; ++ks) pa[ks] = ((const f32x4*)(pp + (size_t)ks * MC * D))[lane + 64 * j];
                f32x4 a = pa[0];
#pragma unroll
                for (int ks = 1; ks < NS; ++ks) a += pa[ks];
                v[j] += pscale * ((const f32x4*)pgate)[lane + 64 * j] * a; } }
#pragma unroll
        for (int j = 0; j < 8; ++j) ss += (v[j].x * v[j].x + v[j].y * v[j].y) + (v[j].z * v[j].z + v[j].w * v[j].w);
        const float rstd = rsqrtf(wave_sum(ss) * (1.f / D) + EPS);
        if ((first && row >= ML) || upd) {
#pragma unroll
            for (int j = 0; j < 8; ++j) ((f32x4*)(xbuf + (size_t)row * D))[lane + 64 * j] = v[j];
        }
#pragma unroll
        for (int j = 0; j < 8; ++j) { const int c4 = lane + 64 * j;
            const f32x4 g = ((const f32x4*)gain)[c4], s1 = ((const f32x4*)sc)[c4], s0 = ((const f32x4*)sh)[c4];
            const f32x4 h = v[j] * rstd * g * (1.f + s1) + s0;
            v2u o; o.x = pk2(h.x, h.y); o.y = pk2(h.z, h.w);
            ((v2u*)(HA + (size_t)row * D))[c4] = o; }
    }
}

__device__ __forceinline__ void lr_block(const Args& args, Frame& F, int l, int rb) {
    PH_IDS;
    const bf16* HA = WSP(bf16, WS_HA); const bf16* W = wptr(F, l, WO_LR); float* LR = WSP(float, WS_LR);
    const int fr = lane & 15, fq = lane >> 4, k0 = 256 * wave;
    f32x4 acc[4][2];
#pragma unroll
    for (int mt = 0; mt < 4; ++mt) { acc[mt][0] = (f32x4){0.f, 0.f, 0.f, 0.f}; acc[mt][1] = acc[mt][0]; }
#pragma unroll 2
    for (int ks = 0; ks < 8; ++ks) { const int k = k0 + 32 * ks + 8 * fq;
        const bf16x8 b0 = *(const bf16x8*)(W + (size_t)fr * D + k), b1 = *(const bf16x8*)(W + (size_t)(16 + fr) * D + k);
#pragma unroll
        for (int mt = 0; mt < 4; ++mt) { const bf16x8 a = *(const bf16x8*)(HA + (size_t)(64 * rb + 16 * mt + fr) * D + k);
            acc[mt][0] = MFMA16(b0, a, acc[mt][0]); acc[mt][1] = MFMA16(b1, a, acc[mt][1]); } }
    LAS float* part = (LAS float*)F.lds;
#pragma unroll
    for (int mt = 0; mt < 4; ++mt)
#pragma unroll
        for (int nt = 0; nt < 2; ++nt) *(LAS f32x4*)(part + wave * 2048 + (16 * mt + fr) * 32 + 16 * nt + 4 * fq) = acc[mt][nt];
    __syncthreads();
    { f32x4 a = *(const LAS f32x4*)(part + tid * 4);
#pragma unroll
      for (int w = 1; w < 8; ++w) a += *(const LAS f32x4*)(part + w * 2048 + tid * 4);
      *(f32x4*)(LR + (size_t)64 * rb * 32 + tid * 4) = a; }
    __syncthreads();
}

__device__ __forceinline__ void phase_prep(const Args& args, Frame& F, int l) {
    PH_IDS;
    const bf16* Z = WSP(bf16, WS_Z); bf16* QN = WSP(bf16, WS_QN); bf16* KN = WSP(bf16, WS_KN); bf16* VN = WSP(bf16, WS_VN);
    const float* qg = args.in[17] + l * 128, * kg = args.in[18] + l * 128, * avg = args.in[10] + l * 512;
    const int hsel = lane >> 5, j5 = lane & 31, hs = j5 >> 4, f0 = (j5 & 15) * 2;
    const int d1 = hs * 64 + f0, d2 = d1 + 32;
    const float invf0 = __powf(10000.f, -(float)f0 * (1.f / 32.f)), invf1 = __powf(10000.f, -(float)(f0 + 1) * (1.f / 32.f));
    const float gq1a = qg[d1], gq1b = qg[d1 + 1], gq2a = qg[d2], gq2b = qg[d2 + 1], gk1a = kg[d1], gk1b = kg[d1 + 1], gk2a = kg[d2], gk2b = kg[d2 + 1];
    unsigned nu1[5], nu2[5]; v4u nraw;
#define PREP_LOAD(r) do { const bf16* _z = Z + (size_t)(r) * INC; _Pragma("unroll") for (int it = 0; it < 5; ++it) { const bf16* _s = it < 4 ? _z + COL_CQ + (2 * it + hsel) * 128 : _z + COL_CK + hsel * 128; \
        nu1[it] = *(const unsigned*)(_s + d1); nu2[it] = *(const unsigned*)(_s + d2); } nraw = *(const v4u*)(_z + COL_AV + lane * 8); } while (0)
    if (gw < MT) PREP_LOAD(gw);
    for (int row = gw; row < MT; row += ngw) {
        unsigned u1[5], u2[5];
#pragma unroll
        for (int it = 0; it < 5; ++it) { u1[it] = nu1[it]; u2[it] = nu2[it]; }
        const v4u raw = nraw;
        if (row + ngw < MT) PREP_LOAD(row + ngw);
        float cs0 = 1.f, sn0 = 0.f, cs1 = 1.f, sn1 = 0.f;
        if (row < ML) { const int t = row & 4095; const float pos = (float)(hs ? (t & 63) : (t >> 6)); cs0 = __cosf(pos * invf0); sn0 = __sinf(pos * invf0); cs1 = __cosf(pos * invf1); sn1 = __sinf(pos * invf1); }
#pragma unroll
        for (int it = 0; it < 5; ++it) {
            const float x1a = blo(u1[it]), x1b = bhi(u1[it]), x2a = blo(u2[it]), x2b = bhi(u2[it]);
            float ss = (x1a * x1a + x1b * x1b) + (x2a * x2a + x2b * x2b);
            ss += __shfl_xor(ss, 1); ss += __shfl_xor(ss, 2); ss += __shfl_xor(ss, 4); ss += __shfl_xor(ss, 8); ss += __shfl_xor(ss, 16);
            const float rstd = rsqrtf(ss * (1.f / 128.f) + EPS);
            const float y1a = x1a * rstd * (it < 4 ? gq1a : gk1a), y1b = x1b * rstd * (it < 4 ? gq1b : gk1b), y2a = x2a * rstd * (it < 4 ? gq2a : gk2a), y2b = x2b * rstd * (it < 4 ? gq2b : gk2b);
            float o1a = y1a * cs0 - y2a * sn0, o2a = y1a * sn0 + y2a * cs0, o1b = y1b * cs1 - y2b * sn1, o2b = y1b * sn1 + y2b * cs1;
            if (it < 4) { o1a *= 0.12751743074602112f; o2a *= 0.12751743074602112f; o1b *= 0.12751743074602112f; o2b *= 0.12751743074602112f; }
            bf16* dst = it < 4 ? QN + (size_t)row * 1024 + (2 * it + hsel) * 128 : KN + (size_t)row * 256 + hsel * 128;
            *(unsigned*)(dst + d1) = pg8::cvt_pk_bf16(o1a, o1b); *(unsigned*)(dst + d2) = pg8::cvt_pk_bf16(o2a, o2b);
        }
        {
            float e[8] = {blo(raw.x), bhi(raw.x), blo(raw.y), bhi(raw.y), blo(raw.z), bhi(raw.z), blo(raw.w), bhi(raw.w)};
            float s = 0.f;
#pragma unroll
            for (int j = 0; j < 8; ++j) { e[j] = gelu_tanh(e[j]); s += e[j]; }
            const float mu = wave_sum(s) * (1.f / 512.f); float q = 0.f;
#pragma unroll
            for (int j = 0; j < 8; ++j) { e[j] -= mu; q += e[j] * e[j]; }
            const float rstd = rsqrtf(wave_sum(q) * (1.f / 512.f) + EPS);
            const f32x4 g0 = *(const f32x4*)(avg + lane * 8), g1 = *(const f32x4*)(avg + lane * 8 + 4);
            v4u o; o.x = pk2(e[0] * rstd * g0.x, e[1] * rstd * g0.y); o.y = pk2(e[2] * rstd * g0.z, e[3] * rstd * g0.w);
            o.z = pk2(e[4] * rstd * g1.x, e[5] * rstd * g1.y); o.w = pk2(e[6] * rstd * g1.z, e[7] * rstd * g1.w);
            *(v4u*)(VN + (size_t)row * 512 + lane * 8) = o;
        }
    }
}

#undef PREP_LOAD
__device__ __forceinline__ bf16x8 tr_frag(const LAS unsigned char* T, int stride, int i0, int i1, int c0, int fr, int fq) {
    const int off = (4 * fq + (fr >> 2)) * stride + (c0 + 4 * (fr & 3)) * 2;
    const s16x4 a = __builtin_amdgcn_ds_read_tr16_b64_v4i16((LAS s16x4*)(T + off + 16 * i0 * stride));
    const s16x4 b = __builtin_amdgcn_ds_read_tr16_b64_v4i16((LAS s16x4*)(T + off + 16 * i1 * stride));
    return (bf16x8){a[0], a[1], a[2], a[3], b[0], b[1], b[2], b[3]};
}
__device__ __forceinline__ bf16x8 rowp_frag(const LAS unsigned char* R, int stride, int i0, int i1, int r0, int fr, int fq) {
    const LAS unsigned char* p = R + (r0 + fr) * stride + 8 * fq;
    const s16x4 a = *(const LAS s16x4*)(p + 32 * i0), b = *(const LAS s16x4*)(p + 32 * i1);
    return (bf16x8){a[0], a[1], a[2], a[3], b[0], b[1], b[2], b[3]};
}
__device__ __forceinline__ v2u pack4(f32x4 v) { v2u o; o.x = pg8::cvt_pk_bf16(v[0], v[1]); o.y = pg8::cvt_pk_bf16(v[2], v[3]); return o; }
__device__ __forceinline__ v4u pack8(const float* e) { v4u o; o.x = pg8::cvt_pk_bf16(e[0], e[1]); o.y = pg8::cvt_pk_bf16(e[2], e[3]); o.z = pg8::cvt_pk_bf16(e[4], e[5]); o.w = pg8::cvt_pk_bf16(e[6], e[7]); return o; }
__device__ __forceinline__ void unpack8(v4u w, float* e) { e[0] = blo(w.x); e[1] = bhi(w.x); e[2] = blo(w.y); e[3] = bhi(w.y); e[4] = blo(w.z); e[5] = bhi(w.z); e[6] = blo(w.w); e[7] = bhi(w.w); }

__device__ __forceinline__ int gla_row0(int b, int c) { return c < 64 ? b * SEQ + 64 * c : ML + b * CTXL + 64 * (c - 64); }
constexpr int GL_LR = 0, GL_W2 = 8192, GL_BS = 16384, GL_BCF = 16896, GL_BCB = GL_BCF + 64 * 65 * 4, GL_OPS = GL_BCB + 64 * 65 * 4;
__device__ __forceinline__ void gla_gates(const Args& args, LAS unsigned char* lds, int l, int h, int row0, int tid) {
    const float* LR = (const float*)(args.ws + WS_LR);
    const float* w2 = args.in[14] + (size_t)l * 2 * 16 * 256, * db = args.in[15] + (size_t)l * 2 * 256;
    LAS float* lrS = (LAS float*)(lds + GL_LR); LAS float* w2S = (LAS float*)(lds + GL_W2); LAS float* bS = (LAS float*)(lds + GL_BS);
    LAS float* BCF = (LAS float*)(lds + GL_BCF); LAS float* BCB = (LAS float*)(lds + GL_BCB);
    *(LAS f32x4*)(lrS + tid * 4) = *(const f32x4*)(LR + (size_t)row0 * 32 + tid * 4);
    { const int j = tid * 4, dr = j >> 6, dk = j & 63; *(LAS f32x4*)(w2S + j) = *(const f32x4*)(w2 + dr * 256 + h * 64 + dk); }
    if (tid < 128) bS[tid] = db[(tid >> 6) * 256 + h * 64 + (tid & 63)];
    __syncthreads();
    { const int t = tid >> 3, dk0 = (tid & 7) * 8;
      float af[8], ab[8];
#pragma unroll
      for (int j = 0; j < 8; ++j) { af[j] = bS[dk0 + j]; ab[j] = bS[64 + dk0 + j]; }
#pragma unroll 4
      for (int r = 0; r < 16; ++r) { const float l0 = lrS[t * 32 + r], l1 = lrS[t * 32 + 16 + r];
#pragma unroll
          for (int j = 0; j < 8; ++j) { af[j] += l0 * w2S[r * 64 + dk0 + j]; ab[j] += l1 * w2S[(16 + r) * 64 + dk0 + j]; } }
#pragma unroll
      for (int j = 0; j < 8; ++j) { BCF[t * 65 + dk0 + j] = log_sigmoid(af[j]) * (1.f / 16.f); BCB[t * 65 + dk0 + j] = log_sigmoid(ab[j]) * (1.f / 16.f); } }
    __syncthreads();
    {
        const int dk = tid & 63, dir = (tid >> 6) & 1, seg = tid >> 7;
        LAS float* B = dir ? BCB : BCF; LAS float* tot = lrS;
        float v[16];
#pragma unroll
        for (int i = 0; i < 16; ++i) v[i] = B[(16 * seg + i) * 65 + dk];
        if (dir == 0) {
#pragma unroll
            for (int i = 1; i < 16; ++i) v[i] += v[i - 1];
        } else {
#pragma unroll
            for (int i = 14; i >= 0; --i) v[i] += v[i + 1];
        }
        tot[(dir * 4 + seg) * 64 + dk] = dir ? v[0] : v[15];
        __syncthreads();
        float off = 0.f;
#pragma unroll
        for (int s2 = 0; s2 < 4; ++s2) { const float tv = tot[(dir * 4 + s2) * 64 + dk]; off += (dir ? (s2 > seg) : (s2 < seg)) ? tv : 0.f; }
#pragma unroll
        for (int i = 0; i < 16; ++i) B[(16 * seg + i) * 65 + dk] = v[i] + off;
    }
    __syncthreads();
}
constexpr int G1_KOF = GL_OPS, G1_KOB = G1_KOF + 64 * 144, G1_V = G1_KOB + 64 * 144, G1_END = G1_V + 64 * 272;
__device__ __forceinline__ void gla1_unit(const Args& args, Frame& F, int l, int u) {
    PH_IDS;
    LAS unsigned char* lds = F.lds;
    const int h = u & 3, bc = u >> 2, b = bc / 68, c = bc % 68, row0 = gla_row0(b, c);
    const bf16* Z = (const bf16*)(args.ws + WS_Z);
    const int t = tid >> 3, dk0 = (tid & 7) * 8, c16 = (tid & 7) * 16;
    const bf16* zr = Z + (size_t)(row0 + t) * INC;
    const v4u kraw = *(const v4u*)(zr + COL_BK + h * 64 + dk0), vraw0 = *(const v4u*)(zr + COL_BV + h * 128 + c16), vraw1 = *(const v4u*)(zr + COL_BV + h * 128 + c16 + 8);
    gla_gates(args, lds, l, h, row0, tid);
    const LAS float* BCF = (const LAS float*)(lds + GL_BCF); const LAS float* BCB = (const LAS float*)(lds + GL_BCB);
    { float k[8], of[8], ob[8]; unpack8(kraw, k);
#pragma unroll
      for (int j = 0; j < 8; ++j) { of[j] = k[j] * __expf(BCF[63 * 65 + dk0 + j] - BCF[t * 65 + dk0 + j]); ob[j] = k[j] * __expf(BCB[dk0 + j] - BCB[t * 65 + dk0 + j]); }
      *(LAS v4u*)(lds + G1_KOF + t * 144 + dk0 * 2) = pack8(of); *(LAS v4u*)(lds + G1_KOB + t * 144 + dk0 * 2) = pack8(ob);
      *(LAS v4u*)(lds + G1_V + t * 272 + c16 * 2) = vraw0;
      *(LAS v4u*)(lds + G1_V + t * 272 + c16 * 2 + 16) = vraw1; }
    if (tid < 128) { const int dir = tid >> 6, dk = tid & 63;
        ((float*)(args.ws + WS_DEC))[((size_t)((b * 4 + h) * 2 + dir) * 68 + c) * 64 + dk] = __expf(dir ? BCB[dk] : BCF[63 * 65 + dk]); }
    __syncthreads();
    { const int fr = lane & 15, fq = lane >> 4, dir = wave >> 2, kt = wave & 3;
      const LAS unsigned char* KO = lds + (dir ? G1_KOB : G1_KOF);
      f32x4 acc[8];
#pragma unroll
      for (int nt = 0; nt < 8; ++nt) acc[nt] = (f32x4){0.f, 0.f, 0.f, 0.f};
#pragma unroll
      for (int ks = 0; ks < 2; ++ks) { const bf16x8 y = tr_frag(KO, 144, 2 * ks, 2 * ks + 1, 16 * kt, fr, fq);
#pragma unroll
          for (int nt = 0; nt < 8; ++nt) { const bf16x8 x = tr_frag(lds + G1_V, 272, 2 * ks, 2 * ks + 1, 16 * nt, fr, fq); acc[nt] = MFMA16(x, y, acc[nt]); } }
      float* st = (float*)(args.ws + WS_ST) + ((size_t)((b * 4 + h) * 2 + dir) * 68 + c) * 8192 + (size_t)(16 * kt + fr) * 128 + 4 * fq;
#pragma unroll
      for (int nt = 0; nt < 8; ++nt) *(f32x4*)(st + 16 * nt) = acc[nt]; }
    __syncthreads();
}
__device__ __forceinline__ void gla_scan(const Args& args, Frame& F) {
    PH_IDS;
    float* ST = (float*)(args.ws + WS_ST); const float* DEC = (const float*)(args.ws + WS_DEC);
    for (int e = blockIdx.x * 512 + tid; e < 32 * 4096; e += F.G * 512) {
        const int chain = e >> 12, idx = (e & 4095) * 2, dk = idx >> 7, dir = chain & 1;
        float* base = ST + (size_t)chain * 68 * 8192 + idx; const float* dbase = DEC + (size_t)chain * 68 * 64 + dk;
        float sx = 0.f, sy = 0.f;
        for (int s0 = 0; s0 < 68; s0 += 8) {
            float kx[8], ky[8], d[8]; int cc[8];
#pragma unroll
            for (int i = 0; i < 8; ++i) { const int s = s0 + i; cc[i] = s < 4 ? (dir ? 67 - s : 64 + s) : (dir ? 67 - s : s - 4);
                if (s < 68) { const float2 v = *(const float2*)(base + (size_t)cc[i] * 8192); kx[i] = v.x; ky[i] = v.y; d[i] = dbase[cc[i] * 64]; } else { kx[i] = 0.f; ky[i] = 0.f; d[i] = 1.f; } }
#pragma unroll
            for (int i = 0; i < 8; ++i) if (s0 + i < 68) { *(float2*)(base + (size_t)cc[i] * 8192) = make_float2(sx, sy); sx = sx * d[i] + kx[i]; sy = sy * d[i] + ky[i]; }
        }
    }
}
constexpr int G3_QF = GL_OPS, G3_QB = G3_QF + 64 * 144, G3_KF = G3_QB + 64 * 144, G3_KB = G3_KF + 64 * 144, G3_V = G3_KB + 64 * 144, G3_SF = G3_V + 64 * 272, G3_SB = G3_SF + 64 * 272,
              G3_END = G3_SB + 64 * 272, G3_P = 0  , G3_XS = 9216;
static_assert(G3_END <= LDSCTL_OFF && G3_XS + 512 <= GL_BCF, "GLA-3 LDS map");
__device__ __forceinline__ void gla3_unit(const Args& args, Frame& F, int l, int u) {
    PH_IDS;
    LAS unsigned char* lds = F.lds;
    const int h = u & 3, bc = u >> 2, b = bc / 68, c = bc % 68, row0 = gla_row0(b, c);
    const bf16* Z = (const bf16*)(args.ws + WS_Z); bf16* ABC = (bf16*)(args.ws + WS_ABC);
    const int t = tid >> 3, dk0 = (tid & 7) * 8, c16 = (tid & 7) * 16;
    const bf16* zr = Z + (size_t)(row0 + t) * INC;
    const v4u kraw = *(const v4u*)(zr + COL_BK + h * 64 + dk0), qraw = *(const v4u*)(zr + COL_BQ + h * 64 + dk0), vraw0 = *(const v4u*)(zr + COL_BV + h * 128 + c16), vraw1 = *(const v4u*)(zr + COL_BV + h * 128 + c16 + 8);
    f32x4 sraw[2][4];
#pragma unroll
    for (int dir = 0; dir < 2; ++dir) { const float* sp = (const float*)(args.ws + WS_ST) + ((size_t)((b * 4 + h) * 2 + dir) * 68 + c) * 8192 + (size_t)t * 128 + c16;
#pragma unroll
        for (int i = 0; i < 4; ++i) sraw[dir][i] = *(const f32x4*)(sp + 4 * i); }
    gla_gates(args, lds, l, h, row0, tid);
    const LAS float* BCF = (const LAS float*)(lds + GL_BCF); const LAS float* BCB = (const LAS float*)(lds + GL_BCB);
    { float k[8], q[8], a[8]; unpack8(kraw, k); unpack8(qraw, q);
      float ef[8], eb[8];
#pragma unroll
      for (int j = 0; j < 8; ++j) { ef[j] = __expf(BCF[t * 65 + dk0 + j]); eb[j] = __expf(BCB[t * 65 + dk0 + j]); }
#pragma unroll
      for (int j = 0; j < 8; ++j) a[j] = q[j] * 0.125f * ef[j];
      *(LAS v4u*)(lds + G3_QF + t * 144 + dk0 * 2) = pack8(a);
#pragma unroll
      for (int j = 0; j < 8; ++j) a[j] = q[j] * 0.125f * eb[j];
      *(LAS v4u*)(lds + G3_QB + t * 144 + dk0 * 2) = pack8(a);
#pragma unroll
      for (int j = 0; j < 8; ++j) a[j] = k[j] * __builtin_amdgcn_rcpf(ef[j]);
      *(LAS v4u*)(lds + G3_KF + t * 144 + dk0 * 2) = pack8(a);
#pragma unroll
      for (int j = 0; j < 8; ++j) a[j] = k[j] * __builtin_amdgcn_rcpf(eb[j]);
      *(LAS v4u*)(lds + G3_KB + t * 144 + dk0 * 2) = pack8(a);
      *(LAS v4u*)(lds + G3_V + t * 272 + c16 * 2) = vraw0;
      *(LAS v4u*)(lds + G3_V + t * 272 + c16 * 2 + 16) = vraw1;
#pragma unroll
      for (int dir = 0; dir < 2; ++dir) { const f32x4 s0 = sraw[dir][0], s1 = sraw[dir][1], s2 = sraw[dir][2], s3 = sraw[dir][3];
          v4u w0, w1; w0.x = pg8::cvt_pk_bf16(s0[0], s0[1]); w0.y = pg8::cvt_pk_bf16(s0[2], s0[3]); w0.z = pg8::cvt_pk_bf16(s1[0], s1[1]); w0.w = pg8::cvt_pk_bf16(s1[2], s1[3]);
          w1.x = pg8::cvt_pk_bf16(s2[0], s2[1]); w1.y = pg8::cvt_pk_bf16(s2[2], s2[3]); w1.z = pg8::cvt_pk_bf16(s3[0], s3[1]); w1.w = pg8::cvt_pk_bf16(s3[2], s3[3]);
          LAS unsigned char* dst = lds + (dir ? G3_SB : G3_SF) + t * 272 + c16 * 2; *(LAS v4u*)dst = w0; *(LAS v4u*)(dst + 16) = w1; } }
    __syncthreads();
    const int fr = lane & 15, fq = lane >> 4, tt = wave & 3, wh = wave >> 2;
    {
        f32x4 af[2], ab[2];
#pragma unroll
        for (int i = 0; i < 2; ++i) { af[i] = (f32x4){0.f, 0.f, 0.f, 0.f}; ab[i] = af[i]; }
#pragma unroll
        for (int ks = 0; ks < 2; ++ks) {
            const bf16x8 qf = *(const LAS bf16x8*)(lds + G3_QF + (16 * tt + fr) * 144 + (32 * ks + 8 * fq) * 2), qb = *(const LAS bf16x8*)(lds + G3_QB + (16 * tt + fr) * 144 + (32 * ks + 8 * fq) * 2);
#pragma unroll
            for (int i = 0; i < 2; ++i) { const int st = 2 * wh + i;
                const bf16x8 kf = *(const LAS bf16x8*)(lds + G3_KF + (16 * st + fr) * 144 + (32 * ks + 8 * fq) * 2), kb = *(const LAS bf16x8*)(lds + G3_KB + (16 * st + fr) * 144 + (32 * ks + 8 * fq) * 2);
                af[i] = MFMA16(kf, qf, af[i]); ab[i] = MFMA16(kb, qb, ab[i]); } }
        const int tq = 16 * tt + fr;
#pragma unroll
        for (int i = 0; i < 2; ++i) { const int s0 = 16 * (2 * wh + i) + 4 * fq; f32x4 p;
#pragma unroll
            for (int j = 0; j < 4; ++j) p[j] = (s0 + j <= tq ? af[i][j] : 0.f) + (s0 + j >= tq ? ab[i][j] : 0.f);
            *(LAS v2u*)(lds + G3_P + tq * 144 + s0 * 2) = pack4(p); }
    }
    __syncthreads();
    {
        f32x4 acc[4];
#pragma unroll
        for (int n = 0; n < 4; ++n) acc[n] = (f32x4){0.f, 0.f, 0.f, 0.f};
#pragma unroll
        for (int seg = 0; seg < 3; ++seg) { const LAS unsigned char* Y = lds + (seg == 0 ? G3_P : seg == 1 ? G3_QF : G3_QB); const LAS unsigned char* X = lds + (seg == 0 ? G3_V : seg == 1 ? G3_SF : G3_SB);
#pragma unroll
            for (int ks = 0; ks < 2; ++ks) { const bf16x8 y = rowp_frag(Y, 144, 2 * ks, 2 * ks + 1, 16 * tt, fr, fq);
#pragma unroll
                for (int n = 0; n < 4; ++n) { const bf16x8 x = tr_frag(X, 272, 2 * ks, 2 * ks + 1, 16 * (4 * wh + n), fr, fq); acc[n] = MFMA16(x, y, acc[n]); } } }
        float ss = 0.f;
#pragma unroll
        for (int n = 0; n < 4; ++n) ss += (acc[n][0] * acc[n][0] + acc[n][1] * acc[n][1]) + (acc[n][2] * acc[n][2] + acc[n][3] * acc[n][3]);
        ss += __shfl_xor(ss, 16); ss += __shfl_xor(ss, 32);
        LAS float* XS = (LAS float*)(lds + G3_XS);
        if (fq == 0) XS[(16 * tt + fr) * 2 + wh] = ss;
        __syncthreads();
        const int to = 16 * tt + fr;
        const float rstd = rsqrtf((XS[to * 2] + XS[to * 2 + 1]) * (1.f / 128.f) + EPS);
        const float* gn = args.in[16] + l * 128;
        const bf16* og = Z + (size_t)(row0 + to) * INC + COL_BG + h * 128; bf16* orow = ABC + (size_t)(row0 + to) * D + 512 + h * 128;
#pragma unroll
        for (int n = 0; n < 4; ++n) { const int dv = 16 * (4 * wh + n) + 4 * fq; const f32x4 g = *(const f32x4*)(gn + dv); const v2u ow = *(const v2u*)(og + dv);
            f32x4 y; y[0] = acc[n][0] * rstd * g[0] * silu_f(blo(ow.x)); y[1] = acc[n][1] * rstd * g[1] * silu_f(bhi(ow.x)); y[2] = acc[n][2] * rstd * g[2] * silu_f(blo(ow.y)); y[3] = acc[n][3] * rstd * g[3] * silu_f(bhi(ow.y));
            *(v2u*)(orow + dv) = pack4(y); }
    }
    __syncthreads();
}

constexpr int GM_WS = 0, GM_VN = 128 * 272;
__device__ __forceinline__ void gmlp_unit(const Args& args, Frame& F, int l, int u) {
    PH_IDS;
    LAS unsigned char* lds = F.lds;
    const int g = u & 3, r0 = (u >> 2) * 128;
    const bf16* Z = (const bf16*)(args.ws + WS_Z); const bf16* VN = (const bf16*)(args.ws + WS_VN); bf16* ABC = (bf16*)(args.ws + WS_ABC);
    const float* ws = args.in[11] + ((size_t)l * 4 + g) * 128 * 128, * bs = args.in[12] + ((size_t)l * 4 + g) * 128;
    { const int p = tid >> 2, q0 = (tid & 3) * 32;
#pragma unroll
      for (int i = 0; i < 4; ++i) { const f32x4 a = *(const f32x4*)(ws + p * 128 + q0 + 8 * i), b2 = *(const f32x4*)(ws + p * 128 + q0 + 8 * i + 4);
          v4u w; w.x = pg8::cvt_pk_bf16(a[0], a[1]); w.y = pg8::cvt_pk_bf16(a[2], a[3]); w.z = pg8::cvt_pk_bf16(b2[0], b2[1]); w.w = pg8::cvt_pk_bf16(b2[2], b2[3]);
          *(LAS v4u*)(lds + GM_WS + p * 272 + (q0 + 8 * i) * 2) = w;
          *(LAS v4u*)(lds + GM_VN + p * 272 + (q0 + 8 * i) * 2) = *(const v4u*)(VN + (size_t)(r0 + p) * 512 + g * 128 + q0 + 8 * i); } }
    __syncthreads();
    { const int fr = lane & 15, fq = lane >> 4, p0 = 16 * wave;
      f32x4 acc[8];
#pragma unroll
      for (int nt = 0; nt < 8; ++nt) acc[nt] = (f32x4){0.f, 0.f, 0.f, 0.f};
#pragma unroll
      for (int ks = 0; ks < 4; ++ks) { const bf16x8 y = rowp_frag(lds + GM_WS, 272, 2 * ks, 2 * ks + 1, p0, fr, fq);
#pragma unroll
          for (int nt = 0; nt < 8; ++nt) { const bf16x8 x = tr_frag(lds + GM_VN, 272, 2 * ks, 2 * ks + 1, 16 * nt, fr, fq); acc[nt] = MFMA16(x, y, acc[nt]); } }
      const int p = p0 + fr; const float bias = bs[p];
      const bf16* ur = Z + (size_t)(r0 + p) * INC + COL_AU + g * 128; bf16* orow = ABC + (size_t)(r0 + p) * D + g * 128;
#pragma unroll
      for (int nt = 0; nt < 8; ++nt) { const int d = 16 * nt + 4 * fq; const v2u uw = *(const v2u*)(ur + d);
          f32x4 y; y[0] = gelu_tanh(blo(uw.x)) * (acc[nt][0] + bias); y[1] = gelu_tanh(bhi(uw.x)) * (acc[nt][1] + bias); y[2] = gelu_tanh(blo(uw.y)) * (acc[nt][2] + bias); y[3] = gelu_tanh(bhi(uw.y)) * (acc[nt][3] + bias);
          *(v2u*)(orow + d) = pack4(y); } }
    __syncthreads();
}

constexpr int AT_K0 = 0, AT_V0 = 2 * 64 * 272, AT_TILE = 64 * 272;
__device__ __forceinline__ void attn_unit(const Args& args, Frame& F, int l, int u) {
    PH_IDS;
    LAS unsigned char* lds = F.lds;
    const bf16* Z = (const bf16*)(args.ws + WS_Z); const bf16* QN = (const bf16*)(args.ws + WS_QN); const bf16* KN = (const bf16*)(args.ws + WS_KN); bf16* ABC = (bf16*)(args.ws + WS_ABC);
    int b, kvh, qb, qrow0, jlo, nloc;
    if (u < 512) { b = u >> 7; kvh = (u >> 6) & 1; qb = u & 63; qrow0 = b * SEQ + 64 * qb; jlo = qb - 2 < 0 ? 0 : qb - 2; const int jhi = qb + 2 > 63 ? 63 : qb + 2; nloc = jhi - jlo + 1; }
    else { const int cu = u - 512; b = cu >> 3; kvh = (cu >> 2) & 1; qb = cu & 3; qrow0 = ML + b * CTXL + 64 * qb; jlo = 0; nloc = 0; }
    const int ntl = nloc + 4;
    const int fr = lane & 15, fq = lane >> 4, h = kvh * 4 + (wave >> 1), qoff = (wave & 1) * 32;
    bf16x8 bq[2][4];
#pragma unroll
    for (int qt = 0; qt < 2; ++qt)
#pragma unroll
        for (int ks = 0; ks < 4; ++ks) bq[qt][ks] = *(const bf16x8*)(QN + (size_t)(qrow0 + qoff + 16 * qt + fr) * 1024 + h * 128 + 32 * ks + 8 * fq);
    const float sink = args.in[19][l * 8 + h] * 1.4426950408889634f;
    float mrun[2] = {sink, sink}, lsum[2] = {1.f, 1.f};
    f32x4 o[8][2];
#pragma unroll
    for (int nt = 0; nt < 8; ++nt) { o[nt][0] = (f32x4){0.f, 0.f, 0.f, 0.f}; o[nt][1] = o[nt][0]; }
    v4u rk[2], rv[2];
    const int srow = tid >> 4, sch = (tid & 15) * 8;
#define AT_LOAD(i) do { const int _r0 = (i) < nloc ? b * SEQ + 64 * (jlo + (i)) : ML + b * CTXL + 64 * ((i) - nloc); \
        _Pragma("unroll") for (int _j = 0; _j < 2; ++_j) { const size_t _r = (size_t)(_r0 + srow + 32 * _j); rk[_j] = *(const v4u*)(KN + _r * 256 + kvh * 128 + sch); rv[_j] = *(const v4u*)(Z + _r * INC + COL_CV + kvh * 128 + sch); } } while (0)
#define AT_STORE(buf) do { _Pragma("unroll") for (int _j = 0; _j < 2; ++_j) { *(LAS v4u*)(lds + AT_K0 + (buf) * AT_TILE + (srow + 32 * _j) * 272 + sch * 2) = rk[_j]; *(LAS v4u*)(lds + AT_V0 + (buf) * AT_TILE + (srow + 32 * _j) * 272 + sch * 2) = rv[_j]; } } while (0)
    AT_LOAD(0); AT_STORE(0);
    __syncthreads();
    for (int i = 0; i < ntl; ++i) {
        if (i + 1 < ntl) AT_LOAD(i + 1);
        const LAS unsigned char* Kb = lds + AT_K0 + (i & 1) * AT_TILE; const LAS unsigned char* Vb = lds + AT_V0 + (i & 1) * AT_TILE;
        f32x4 s[4][2];
#pragma unroll
        for (int kt = 0; kt < 4; ++kt) { s[kt][0] = (f32x4){0.f, 0.f, 0.f, 0.f}; s[kt][1] = s[kt][0]; }
#pragma unroll
        for (int ks = 0; ks < 4; ++ks)
#pragma unroll
            for (int kt = 0; kt < 4; ++kt) { const bf16x8 a = *(const LAS bf16x8*)(Kb + (16 * kt + fr) * 272 + (32 * ks + 8 * fq) * 2);
                s[kt][0] = MFMA16(a, bq[0][ks], s[kt][0]); s[kt][1] = MFMA16(a, bq[1][ks], s[kt][1]); }
        if (i < nloc) { const int jt = jlo + i;
            if (jt == qb - 2 || jt == qb + 2) {
#pragma unroll
                for (int qt = 0; qt < 2; ++qt) { const int qpos = 64 * qb + qoff + 16 * qt + fr;
#pragma unroll
                    for (int kt = 0; kt < 4; ++kt)
#pragma unroll
                        for (int j = 0; j < 4; ++j) { const int dlt = qpos - (64 * jt + 16 * kt + 4 * fq + j); if (dlt > 128 || dlt < -128) s[kt][qt][j] = -__builtin_inff(); } } } }
        bf16x8 pf[2][2];
#pragma unroll
        for (int qt = 0; qt < 2; ++qt) {
            float mx = s[0][qt][0];
#pragma unroll
            for (int kt = 0; kt < 4; ++kt)
#pragma unroll
                for (int j = 0; j < 4; ++j) mx = fmaxf(mx, s[kt][qt][j]);
            mx = fmaxf(mx, __shfl_xor(mx, 16)); mx = fmaxf(mx, __shfl_xor(mx, 32));
            if (__any(mx - mrun[qt] > 8.f)) {
                const float mn = fmaxf(mrun[qt], mx), alpha = __builtin_amdgcn_exp2f(mrun[qt] - mn); mrun[qt] = mn; lsum[qt] *= alpha;
#pragma unroll
                for (int nt = 0; nt < 8; ++nt) o[nt][qt] *= alpha; }
            const float mref = mrun[qt]; float rs = 0.f;
#pragma unroll
            for (int kt = 0; kt < 4; ++kt)
#pragma unroll
                for (int j = 0; j < 4; ++j) { const float p = __builtin_amdgcn_exp2f(s[kt][qt][j] - mref); s[kt][qt][j] = p; rs += p; }
            rs += __shfl_xor(rs, 16); rs += __shfl_xor(rs, 32);
            lsum[qt] += rs;
#pragma unroll
            for (int kp = 0; kp < 2; ++kp) { const v2u lo = pack4(s[2 * kp][qt]), hi = pack4(s[2 * kp + 1][qt]); const v4u w = {lo.x, lo.y, hi.x, hi.y}; pf[qt][kp] = __builtin_bit_cast(bf16x8, w); }
        }
#pragma unroll
        for (int kp = 0; kp < 2; ++kp)
#pragma unroll
            for (int nt = 0; nt < 8; ++nt) { const bf16x8 x = tr_frag(Vb, 272, 2 * kp, 2 * kp + 1, 16 * nt, fr, fq);
                o[nt][0] = MFMA16(x, pf[0][kp], o[nt][0]); o[nt][1] = MFMA16(x, pf[1][kp], o[nt][1]); }
        if (i + 1 < ntl) AT_STORE((i + 1) & 1);
        __syncthreads();
    }
#undef AT_LOAD
#undef AT_STORE
#pragma unroll
    for (int qt = 0; qt < 2; ++qt) { const float inv = 1.f / lsum[qt]; bf16* orow = ABC + (size_t)(qrow0 + qoff + 16 * qt + fr) * D + 1024 + h * 128 + 4 * fq;
#pragma unroll
        for (int nt = 0; nt < 8; ++nt) *(v2u*)(orow + 16 * nt) = pack4(o[nt][qt] * inv); }
}

constexpr int NPL = 13, NPH = 1 + 2 * NPL;
__global__ void __launch_bounds__(NWAVES * 64, 2) fwd_kernel(Args args) {
    extern __shared__ __attribute__((aligned(16))) unsigned char lds[];
    Frame F;
    F.lds = (LAS unsigned char*)lds;
    F.tid = threadIdx.x; F.lane = F.tid & 63; F.wave = __builtin_amdgcn_readfirstlane(F.tid >> 6);
    F.G = gridDim.x; F.gw = blockIdx.x * NWAVES + F.wave; F.ngw = F.G * NWAVES;
    F.ws = args.ws;
    volatile LAS unsigned* MISC = (volatile LAS unsigned*)(F.lds + MISC_OFF);
    for (int u = F.tid; u < (LDS_BYTES - LDSCTL_OFF) / 4; u += NWAVES * 64) ((LAS unsigned*)(F.lds + LDSCTL_OFF))[u] = 0u;
    __syncthreads();
    const int lo = args.ph_lo, hi = args.ph_hi;
    XcdBarrier bar; bar.bar = (unsigned*)(F.ws + WS_CTL) + CW_BAR; bar.x = 0; bar.st = nullptr;
    if (hi - lo > 1) bar = xcd_barrier_post((unsigned*)(F.ws + WS_CTL) + CW_BAR, MISC + 8);
#ifndef PHMASK
#define PHMASK 0xFFFF
#endif
#define EN(j) ((PHMASK >> (j)) & 1)
#ifndef PROBE_DUP
#define PROBE_DUP 0x0
#endif
#define REPS(j) (1 + ((PROBE_DUP >> (j)) & 1))
#define IN(k) (lo <= (k) && (k) < hi)
#define SEAM(k) do { if (IN(k) && IN((k) + 1)) xcd_barrier(bar); } while (0)
    PG8_LAS unsigned char* ring = (PG8_LAS unsigned char*)(F.lds + RING_OFF);
    const int bx = blockIdx.x;

    if (EN(15) && IN(0)) for (int rep = 0; rep < REPS(15); ++rep) { phase_prologue(args, F); } SEAM(0);

    for (int l = 0; l < 2; ++l) {
        const int P = 1 + l * NPL;
        const bool lastl = (l == 1);
        bf16* HA = WSP(bf16, WS_HA); bf16* ACT = WSP(bf16, WS_Z); bf16* Zb = WSP(bf16, WS_Z); bf16* ABC = WSP(bf16, WS_ABC);
        float* xbuf = WSP(float, WS_XBUF);
        const float* PNONE = nullptr;
        bf16* HAc = HA + (size_t)ML * D; bf16* ACTc = ACT + (size_t)ML * FFN; bf16* ABCc = ABC + (size_t)ML * D;
        float* PART = WSP(float, WS_PART);
        if (EN(0) && IN(P + 0)) for (int rep = 0; rep < REPS(0); ++rep) { phase_norm<4>(args, F, l, 0, l == 0, MT, (l == 1 && rep == 0) ? modp(F, 0, 4, 8) : PNONE, 0.5f); } SEAM(P + 0);
        if (EN(1) && IN(P + 1)) for (int rep = 0; rep < REPS(1); ++rep) {
            { pg8::Gemm g{HA, wptr(F, l, WO_UP), D, D}; pg8::TwoPartOrder S; S.init(2 * FFN / 256, D, 2 * FFN / 256, 1, D, F.G, bx);
              pg8::EpiUp E{ACT, FFN, 0}; pg8::gemm_phase<pg8::EpiUp, pg8::TwoPartOrder>(ring, g, S, E); }
            if (rep == 0) conv_slot(args, F, cq_start(l, 0), l == 0 ? CQ_N[0][0] : CQ_N[1][0], bx - 176, 80);
            } SEAM(P + 1);
        if (EN(2) && IN(P + 2)) for (int rep = 0; rep < REPS(2); ++rep) {
            { pg8::Gemm g{ACT, wptr(F, l, WO_DN), FFN, FFN}; pg8::TwoPartOrder S; S.init(D / 256, FFN, D / 256, 4, FFN / 4, F.G, bx);
              pg8::EpiResidPart E{{l == 0 ? args.in[0] : xbuf, xbuf, modp(F, l, 0, 2), NMOD * D, rep + 1 == REPS(2) ? 0.5f : 0.f}, {PART}}; pg8::gemm_phase<pg8::EpiResidPart, pg8::TwoPartOrder>(ring, g, S, E); }
            if (rep == 0) conv_slot(args, F, cq_start(l, 1), l == 0 ? CQ_N[0][1] : CQ_N[1][1], bx - 128, 128);
            } SEAM(P + 2);
        if (EN(3) && IN(P + 3)) for (int rep = 0; rep < REPS(3); ++rep) { phase_norm<4>(args, F, l, 1, false, MT, rep == 0 ? modp(F, l, 4, 2) : PNONE, 0.5f); } SEAM(P + 3);
        if (EN(4) && IN(P + 4)) for (int rep = 0; rep < REPS(4); ++rep) {
            { pg8::Gemm g{HA, wptr(F, l, WO_IN), D, D}; pg8::TwoPartOrder S; S.init(INC / 256, D, (lastl ? 1280 : INC) / 256, 1, D, F.G, bx);
              pg8::EpiBf16 E{Zb, INC, 0, rep + 1 < REPS(4), COL_GATE / 256}; pg8::gemm_phase<pg8::EpiBf16, pg8::TwoPartOrder>(ring, g, S, E); }
            for (int rb = (bx + 192) % F.G; rb < MT / 64; rb += F.G) lr_block(args, F, l, rb);
            if (rep == 0) { if (l == 0) conv_slot(args, F, cq_start(0, 2), CQ_N[0][2], bx - 160, 96); else conv_slot(args, F, cq_start(1, 2), CQ_N[1][2], bx - 20, 236); }
        } SEAM(P + 4);
        if (EN(5) && IN(P + 5)) for (int rep = 0; rep < REPS(5); ++rep) { phase_prep(args, F, l); __syncthreads(); for (int u = bx; u < 4 * 4 * 68; u += F.G) gla1_unit(args, F, l, u); } SEAM(P + 5);
        if (EN(6) && IN(P + 6)) for (int rep = 0; rep < REPS(6); ++rep) { if (rep == 0) gla_scan(args, F);
            for (int u = bx; u < 512; u += F.G) attn_unit(args, F, l, u);
            __syncthreads();
            for (int u = (bx + 96) % F.G; u < 4 * ((lastl ? ML : MT) / 128); u += F.G) gmlp_unit(args, F, l, u); } SEAM(P + 6);
        if (EN(7) && IN(P + 7)) for (int rep = 0; rep < REPS(7); ++rep) { if (l == 0) { for (int u = 512 + bx; u < 544; u += F.G) attn_unit(args, F, l, u); __syncthreads(); }
            for (int u = (bx + 224) % F.G; u < 4 * 4 * (lastl ? 64 : 68); u += F.G) gla3_unit(args, F, l, lastl ? (u & 3) + 4 * ((u >> 2) % 64 + 68 * (u >> 8)) : u); } SEAM(P + 7);
        const int nMm = (lastl ? ML : MT) / 256;
        if (EN(8) && IN(P + 8)) for (int rep = 0; rep < REPS(8); ++rep) { pg8::Gemm g{ABC, wptr(F, l, WO_BRA), D, D}; pg8::MergeOrder S; S.init(nMm, D / 256, F.G, bx);
            pg8::EpiMergeR E{Zb + COL_GATE, INC, HA}; pg8::gemm_phase<pg8::EpiMergeR, pg8::MergeOrder>(ring, g, S, E);
            if (l == 0 && rep == 0) conv_slot(args, F, cq_start(0, 3), CQ_N[0][3], bx - 32, 224);
            } SEAM(P + 8);
        if (EN(9) && IN(P + 9)) for (int rep = 0; rep < REPS(9); ++rep) {
            { pg8::Gemm g{HA, wptr(F, l, WO_OUT), D, D}; pg8::TwoPartOrder S; S.init(D / 256, D, lastl ? 0 : D / 256, 8, D / 8, F.G, bx);
              pg8::EpiResidPart E{{xbuf, xbuf, modp(F, l, 0, 5), NMOD * D, rep + 1 == REPS(9) ? 1.0f : 0.f}, {PART}}; pg8::gemm_phase<pg8::EpiResidPart, pg8::TwoPartOrder>(ring, g, S, E); } } SEAM(P + 9);
        if (EN(10) && IN(P + 10)) for (int rep = 0; rep < REPS(10); ++rep) { phase_norm<8>(args, F, l, 2, false, lastl ? ML : MT, (!lastl && rep == 0) ? modp(F, l, 4, 5) : PNONE, 1.0f); } SEAM(P + 10);
        if (EN(11) && IN(P + 11)) for (int rep = 0; rep < REPS(11); ++rep) {
            { pg8::Gemm g{HA, wptr(F, l, WO_UP + W_UP_E), D, D}; pg8::TwoPartOrder S; S.init(2 * FFN / 256, D, lastl ? 0 : 2 * FFN / 256, 1, D, F.G, bx);
              pg8::EpiUp E{ACT, FFN, 0}; pg8::gemm_phase<pg8::EpiUp, pg8::TwoPartOrder>(ring, g, S, E); }
            if (l == 0 && rep == 0) conv_slot(args, F, cq_start(0, 4), CQ_N[0][4], bx - 176, 80);
            } SEAM(P + 11);
        if (EN(12) && IN(P + 12)) for (int rep = 0; rep < REPS(12); ++rep) {
            { pg8::Gemm g{ACT, wptr(F, l, WO_DN + W_DN_E), FFN, FFN}; pg8::TwoPartOrder S; S.init(D / 256, FFN, lastl ? 0 : D / 256, 4, FFN / 4, F.G, bx);
              pg8::EpiResidPart E{{xbuf, (lastl && rep + 1 == REPS(12)) ? args.out : xbuf, modp(F, l, 0, 8), NMOD * D, rep + 1 == REPS(12) ? 0.5f : 0.f}, {PART}}; pg8::gemm_phase<pg8::EpiResidPart, pg8::TwoPartOrder>(ring, g, S, E); }
            if (l == 0 && rep == 0) conv_slot(args, F, cq_start(0, 5), CQ_N[0][5], bx - 128, 128);
            }
        if (!lastl) SEAM(P + 12);
    }
#undef IN
#undef SEAM
}

extern "C" void kernel_launch(void* const* d_in, const int* in_sizes, int n_in, void* d_out, int out_size, void* d_ws, size_t ws_size, hipStream_t stream) {
    static int grid = 0;
    if (grid == 0) {
        if (n_in != 24 || out_size != ML * D || ws_size < WS_END) { fprintf(stderr, "kernel_launch: unexpected shapes (n_in %d out %d ws %zu need %zu)\n", n_in, out_size, ws_size, (size_t)WS_END); grid = -1; return; }
        int dev = 0, cus = 0, per_cu = 0;
        if (hipGetDevice(&dev) != hipSuccess || hipDeviceGetAttribute(&cus, hipDeviceAttributeMultiprocessorCount, dev) != hipSuccess) { grid = -1; return; }
        if (hipFuncSetAttribute((const void*)fwd_kernel, hipFuncAttributeMaxDynamicSharedMemorySize, LDS_BYTES) != hipSuccess) { fprintf(stderr, "kernel_launch: hipFuncSetAttribute failed\n"); grid = -1; return; }
        if (hipOccupancyMaxActiveBlocksPerMultiprocessor(&per_cu, (const void*)fwd_kernel, NWAVES * 64, LDS_BYTES) != hipSuccess || per_cu < 1)
            fprintf(stderr, "kernel_launch: occupancy query reports %d blocks per CU\n", per_cu);
        (void)hipGetLastError();
        grid = cus;
    }
    if (grid < 0) return;
    if (hipMemsetAsync((char*)d_ws + WS_CTL, 0, CTL_ZERO_BYTES, stream) != hipSuccess) return;
    Args a{};
    for (int i = 0; i < 24; ++i) a.in[i] = (const float*)d_in[i];
    a.out = (float*)d_out; a.ws = (unsigned char*)d_ws;
#if N_LAUNCH_MODE == 1
    a.ph_lo = 0; a.ph_hi = NPH;
    hipLaunchKernelGGL(fwd_kernel, dim3(grid), dim3(NWAVES * 64), LDS_BYTES, stream, a);
#else
    for (int p = 0; p < NPH; ++p) { a.ph_lo = p; a.ph_hi = p + 1; hipLaunchKernelGGL(fwd_kernel, dim3(grid), dim3(NWAVES * 64), LDS_BYTES, stream, a); }
#endif
}
```
